# Optimizing an MI355X kernel written in HIP

```python
import math
import jax
import jax.numpy as jnp
from jax import lax
import numpy as np

D_MODEL = 1024
BATCH = 8
SEQ = 4096
DEPTH = 1

PLE_DIM = 256
EPS = 1e-6

D_RNN = 1024
RNN_BLOCKS = 8
RNN_BLOCK = D_RNN // RNN_BLOCKS
CONV_W = 4
LRU_C = 8.0

N_HEADS = 8
N_KV = 2
HPG = N_HEADS // N_KV
HEAD_DIM = 128
D_ATTN = N_HEADS * HEAD_DIM
CMP_LEN = 32
CMP_STRIDE = 16
CMP_HID = 256
SEL_BLOCK = 64
SEL_TOPK = 16
WINDOW = 512
Q_BLOCK = 32
ROPE_THETA = 10000.0

PEER_HEADS = 8
N_KEYS = 128
N_EXPERTS = N_KEYS * N_KEYS
PEER_QDIM = 128
PEER_HALF = PEER_QDIM // 2
PEER_TOPK = 16
PEER_CHUNK = 128

SPLIT_SIZES = (D_RNN, D_RNN, D_ATTN, 6 * N_KV * HEAD_DIM, 3 * N_HEADS, 2 * D_MODEL)
D_IN = sum(SPLIT_SIZES)
SPLIT_POINTS = tuple(int(v) for v in np.cumsum(SPLIT_SIZES)[:-1])

NEG_INF = -1e30
FORCE_SCORE = 1e3

kernel_name = 'hybrid_rglru_nsa_peer'


def rmsnorm(x, g):
    xf = x.astype(jnp.float32)
    y = xf * lax.rsqrt(jnp.mean(xf * xf, axis=-1, keepdims=True) + EPS)
    return (y * g.astype(jnp.float32)).astype(x.dtype)


def rope(x, pos):
    half = HEAD_DIM // 2
    inv = ROPE_THETA ** (-jnp.arange(half, dtype=jnp.float32) / half)
    ang = pos.astype(jnp.float32)[..., None] * inv
    cos = jnp.cos(ang)[:, :, None, :]
    sin = jnp.sin(ang)[:, :, None, :]
    xf = x.astype(jnp.float32)
    x1, x2 = xf[..., :half], xf[..., half:]
    return jnp.concatenate([x1 * cos - x2 * sin, x2 * cos + x1 * sin], axis=-1).astype(x.dtype)


def causal_dwconv(x, w, b):
    y = lax.conv_general_dilated(x, w[:, None, :].astype(x.dtype), window_strides=(1,),
                                 padding=[(CONV_W - 1, 0)], dimension_numbers=('NWC', 'WIO', 'NWC'),
                                 feature_group_count=x.shape[-1])
    return y + b


def rg_lru(x, w_r, b_r, w_i, b_i, lam):
    B, S, C = x.shape
    xf = x.astype(jnp.float32)
    xb = xf.reshape(B, S, RNN_BLOCKS, RNN_BLOCK)
    r = jax.nn.sigmoid(jnp.einsum('bsnc,ncd->bsnd', xb, w_r.astype(jnp.float32)).reshape(B, S, C) + b_r)
    ig = jax.nn.sigmoid(jnp.einsum('bsnc,ncd->bsnd', xb, w_i.astype(jnp.float32)).reshape(B, S, C) + b_i)
    log_a = -LRU_C * r * jax.nn.softplus(-lam.astype(jnp.float32))
    a = jnp.exp(log_a)
    u = jnp.sqrt(-jnp.expm1(2.0 * log_a)) * (ig * xf)

    def combine(lhs, rhs):
        a1, b1 = lhs
        a2, b2 = rhs
        return a1 * a2, a2 * b1 + b2

    _, hs = lax.associative_scan(combine, (a, u), axis=1)
    return hs.astype(x.dtype)


def compress_blocks(t, idx, pe, w1, b1, w2, b2):
    blk = t[:, idx] + pe[:, None, :]
    B, n = blk.shape[0], blk.shape[1]
    flat = blk.transpose(0, 3, 1, 2, 4).reshape(B, N_KV, n, CMP_LEN * HEAD_DIM)
    hid = jax.nn.gelu(jnp.einsum('bgnf,fh->bgnh', flat, w1) + b1)
    return jnp.einsum('bgnh,hd->bgnd', hid, w2) + b2


def masked_softmax(s, mask):
    return jax.nn.softmax(jnp.where(mask, s, NEG_INF), axis=-1)


def nsa_attention(q, kv, gate_logits, pos, cmp_k, cmp_v):
    B, S = q.shape[0], q.shape[1]
    f32 = jnp.float32
    kv = kv.reshape(B, S, 6, N_KV, HEAD_DIM)
    k_c, v_c, k_s, v_s, k_w, v_w = (kv[:, :, j] for j in range(6))
    q = q.reshape(B, S, N_HEADS, HEAD_DIM)
    q_rot = rope(q, pos)
    k_s = rope(k_s, pos)
    k_w = rope(k_w, pos)

    def heads_first(t):
        return t.reshape(B, S, N_KV, HPG, HEAD_DIM).transpose(0, 2, 3, 1, 4)

    q_n = heads_first(q)
    q_r = heads_first(q_rot)
    gates = jax.nn.sigmoid(gate_logits.astype(f32)).reshape(B, S, N_KV, HPG, 3).transpose(0, 2, 3, 1, 4)

    n_cmp = (S - CMP_LEN) // CMP_STRIDE + 1
    cmp_start = jnp.arange(n_cmp) * CMP_STRIDE
    cmp_idx = cmp_start[:, None] + jnp.arange(CMP_LEN)[None, :]
    cmp_end = cmp_start + CMP_LEN - 1
    kc = compress_blocks(k_c, cmp_idx, *cmp_k)
    vc = compress_blocks(v_c, cmp_idx, *cmp_v)

    n_sel = S // SEL_BLOCK
    sel_start = jnp.arange(n_sel) * SEL_BLOCK
    overlap = ((cmp_start[:, None] < sel_start[None, :] + SEL_BLOCK) &
               (cmp_end[:, None] >= sel_start[None, :])).astype(f32)
    top_n = min(SEL_TOPK, n_sel)
    ks_blk = k_s.reshape(B, n_sel, SEL_BLOCK, N_KV, HEAD_DIM).transpose(0, 3, 1, 2, 4)
    vs_blk = v_s.reshape(B, n_sel, SEL_BLOCK, N_KV, HEAD_DIM).transpose(0, 3, 1, 2, 4)

    kw_pad = jnp.pad(k_w.transpose(0, 2, 1, 3), ((0, 0), (0, 0), (WINDOW, 0), (0, 0)))
    vw_pad = jnp.pad(v_w.transpose(0, 2, 1, 3), ((0, 0), (0, 0), (WINDOW, 0), (0, 0)))

    scale = HEAD_DIM ** -0.5
    b_ix = jnp.arange(B)[:, None, None, None]
    g_ix = jnp.arange(N_KV)[None, :, None, None]
    j_sel = jnp.arange(n_sel)

    def block(c):
        t0 = c * Q_BLOCK
        tq = t0 + jnp.arange(Q_BLOCK)
        qn = lax.dynamic_slice_in_dim(q_n, t0, Q_BLOCK, axis=3)
        qr = lax.dynamic_slice_in_dim(q_r, t0, Q_BLOCK, axis=3)
        gt = lax.dynamic_slice_in_dim(gates, t0, Q_BLOCK, axis=3)

        s_c = jnp.einsum('bghtd,bgnd->bghtn', qn, kc, preferred_element_type=f32) * scale
        m_c = cmp_end[None, :] <= tq[:, None]
        p_c = masked_softmax(s_c, m_c) * (tq >= CMP_LEN - 1).astype(f32)[:, None]
        o_c = jnp.einsum('bghtn,bgnd->bghtd', p_c.astype(vc.dtype), vc)

        imp = jnp.einsum('bghtn,nj->bgtj', p_c, overlap)
        cur = tq // SEL_BLOCK
        forced = (j_sel[None, :] == 0) | (j_sel[None, :] == cur[:, None]) | (j_sel[None, :] == cur[:, None] - 1)
        imp = jnp.where(forced, FORCE_SCORE, imp)
        imp = jnp.where(sel_start[None, :] <= tq[:, None], imp, NEG_INF)
        top_v, top_i = lax.top_k(imp, top_n)

        ks = ks_blk[b_ix, g_ix, top_i].reshape(B, N_KV, Q_BLOCK, top_n * SEL_BLOCK, HEAD_DIM)
        vs = vs_blk[b_ix, g_ix, top_i].reshape(B, N_KV, Q_BLOCK, top_n * SEL_BLOCK, HEAD_DIM)
        kpos = (top_i[..., None] * SEL_BLOCK + jnp.arange(SEL_BLOCK)).reshape(B, N_KV, Q_BLOCK, top_n * SEL_BLOCK)
        m_s = (kpos <= tq[None, None, :, None]) & jnp.repeat(top_v > 0.5 * NEG_INF, SEL_BLOCK, axis=-1)
        s_s = jnp.einsum('bghtd,bgtkd->bghtk', qr, ks, preferred_element_type=f32) * scale
        p_s = masked_softmax(s_s, m_s[:, :, None])
        o_s = jnp.einsum('bghtk,bgtkd->bghtd', p_s.astype(vs.dtype), vs)

        kw = lax.dynamic_slice_in_dim(kw_pad, t0, Q_BLOCK + WINDOW, axis=2)
        vw = lax.dynamic_slice_in_dim(vw_pad, t0, Q_BLOCK + WINDOW, axis=2)
        wpos = t0 - WINDOW + jnp.arange(Q_BLOCK + WINDOW)
        dist = tq[:, None] - wpos[None, :]
        m_w = (wpos[None, :] >= 0) & (dist >= 0) & (dist < WINDOW)
        s_w = jnp.einsum('bghtd,bgkd->bghtk', qr, kw, preferred_element_type=f32) * scale
        p_w = masked_softmax(s_w, m_w)
        o_w = jnp.einsum('bghtk,bgkd->bghtd', p_w.astype(vw.dtype), vw)

        return gt[..., 0:1] * o_c + gt[..., 1:2] * o_s + gt[..., 2:3] * o_w

    o = lax.map(block, jnp.arange(S // Q_BLOCK))
    return o.transpose(1, 0, 4, 2, 3, 5).reshape(B, S, D_ATTN)


def peer_ffn(x, w_q, sub_keys, u_tab, v_tab):
    B, S, D = x.shape
    T = B * S
    xt = x.reshape(T, D)
    q = jnp.einsum('td,de->te', xt, w_q).reshape(T, PEER_HEADS, 2, PEER_HALF)
    s = jnp.einsum('thcq,cnq->thcn', q, sub_keys, preferred_element_type=jnp.float32)
    v1, i1 = lax.top_k(s[:, :, 0], PEER_TOPK)
    v2, i2 = lax.top_k(s[:, :, 1], PEER_TOPK)
    cand = (v1[..., :, None] + v2[..., None, :]).reshape(T, PEER_HEADS, PEER_TOPK * PEER_TOPK)
    best, ci = lax.top_k(cand, PEER_TOPK)
    e_idx = (jnp.take_along_axis(i1, ci // PEER_TOPK, axis=-1) * N_KEYS +
             jnp.take_along_axis(i2, ci % PEER_TOPK, axis=-1))
    g = jax.nn.softmax(best, axis=-1).astype(x.dtype)
    n_chunks = T // PEER_CHUNK

    def chunk(args):
        xc, ec, gc = args
        u = u_tab[ec]
        act = jax.nn.gelu(jnp.einsum('cd,chkd->chk', xc, u)) * gc
        v = v_tab[ec]
        return jnp.einsum('chk,chkd->cd', act, v)

    out = lax.map(chunk, (xt.reshape(n_chunks, PEER_CHUNK, D),
                          e_idx.reshape(n_chunks, PEER_CHUNK, PEER_HEADS, PEER_TOPK),
                          g.reshape(n_chunks, PEER_CHUNK, PEER_HEADS, PEER_TOPK)))
    return out.reshape(B, S, D)


def setup_inputs(seed: int = 0) -> dict:
    key = jax.random.key(seed)
    keys = jax.random.split(key, 48)
    counter = [0]
    f32 = jnp.float32

    def nxt():
        k = keys[counter[0]]
        counter[0] += 1
        return k

    def nrm(shape, scale):
        return jax.random.normal(nxt(), shape, f32) * scale

    def gain(shape):
        return 1.0 + nrm(shape, 0.01)

    L = DEPTH
    x = nrm((BATCH, SEQ, D_MODEL), 1.0)
    p = nrm((DEPTH, BATCH, SEQ, PLE_DIM), 1.0)
    offsets = jax.random.randint(nxt(), (BATCH, 1), 0, 1024, dtype=jnp.int32)
    positions = offsets + jnp.arange(SEQ, dtype=jnp.int32)[None, :]
    u = jax.random.uniform(nxt(), (L, D_RNN), f32, 0.9, 0.999)
    s = u ** (1.0 / LRU_C)
    lru_lam = jnp.log(s) - jnp.log1p(-s)
    fl = CMP_LEN * HEAD_DIM
    return {
        'x': x,
        'p': p,
        'positions': positions,
        'norm_mix': gain((L, D_MODEL)),
        'w_in': nrm((L, D_MODEL, D_IN), D_MODEL ** -0.5),
        'conv_w': nrm((L, CONV_W, D_RNN), CONV_W ** -0.5),
        'conv_b': nrm((L, D_RNN), 0.01),
        'lru_wr': nrm((L, RNN_BLOCKS, RNN_BLOCK, RNN_BLOCK), RNN_BLOCK ** -0.5),
        'lru_br': nrm((L, D_RNN), 0.01),
        'lru_wi': nrm((L, RNN_BLOCKS, RNN_BLOCK, RNN_BLOCK), RNN_BLOCK ** -0.5),
        'lru_bi': nrm((L, D_RNN), 0.01),
        'lru_lam': lru_lam,
        'cmp_pe_k': nrm((L, CMP_LEN, HEAD_DIM), 0.02),
        'cmp_w1_k': nrm((L, fl, CMP_HID), fl ** -0.5),
        'cmp_b1_k': nrm((L, CMP_HID), 0.01),
        'cmp_w2_k': nrm((L, CMP_HID, HEAD_DIM), CMP_HID ** -0.5),
        'cmp_b2_k': nrm((L, HEAD_DIM), 0.01),
        'cmp_pe_v': nrm((L, CMP_LEN, HEAD_DIM), 0.02),
        'cmp_w1_v': nrm((L, fl, CMP_HID), fl ** -0.5),
        'cmp_b1_v': nrm((L, CMP_HID), 0.01),
        'cmp_w2_v': nrm((L, CMP_HID, HEAD_DIM), CMP_HID ** -0.5),
        'cmp_b2_v': nrm((L, HEAD_DIM), 0.01),
        'w_a': nrm((L, D_RNN, D_MODEL), D_RNN ** -0.5),
        'w_b': nrm((L, D_ATTN, D_MODEL), D_ATTN ** -0.5),
        'w_out': nrm((L, D_MODEL, D_MODEL), D_MODEL ** -0.5),
        'norm_ffn': gain((L, D_MODEL)),
        'peer_wq': nrm((L, D_MODEL, PEER_HEADS * PEER_QDIM), D_MODEL ** -0.5),
        'peer_keys': nrm((L, 2, N_KEYS, PEER_HALF), PEER_HALF ** -0.5),
        'peer_u': nrm((L, N_EXPERTS, D_MODEL), D_MODEL ** -0.5),
        'peer_v': nrm((L, N_EXPERTS, D_MODEL), PEER_HEADS ** -0.5),
        'norm_ple': gain((L, D_MODEL)),
        'ple_wg': nrm((L, D_MODEL, D_MODEL), D_MODEL ** -0.5),
        'ple_wp': nrm((L, PLE_DIM, D_MODEL), PLE_DIM ** -0.5),
        'norm_final': gain((D_MODEL,)),
    }


def reference(x, p, positions, norm_mix, w_in, conv_w, conv_b, lru_wr, lru_br, lru_wi, lru_bi, lru_lam,
              cmp_pe_k, cmp_w1_k, cmp_b1_k, cmp_w2_k, cmp_b2_k, cmp_pe_v, cmp_w1_v, cmp_b1_v, cmp_w2_v, cmp_b2_v,
              w_a, w_b, w_out, norm_ffn, peer_wq, peer_keys, peer_u, peer_v, norm_ple, ple_wg, ple_wp,
              norm_final):
    B, S, D = x.shape
    h = x
    for i in range(DEPTH):
        n = rmsnorm(h, norm_mix[i])
        z = jnp.einsum('bsd,de->bse', n, w_in[i])
        z_rx, z_rg, z_q, z_kv, z_ng, z_m = jnp.split(z, SPLIT_POINTS, axis=-1)

        xa = causal_dwconv(z_rx, conv_w[i], conv_b[i])
        ha = rg_lru(xa, lru_wr[i], lru_br[i], lru_wi[i], lru_bi[i], lru_lam[i])
        y_a = jnp.einsum('bsc,cd->bsd', ha * jax.nn.gelu(z_rg), w_a[i])

        o_b = nsa_attention(z_q, z_kv, z_ng, positions,
                            (cmp_pe_k[i], cmp_w1_k[i], cmp_b1_k[i], cmp_w2_k[i], cmp_b2_k[i]),
                            (cmp_pe_v[i], cmp_w1_v[i], cmp_b1_v[i], cmp_w2_v[i], cmp_b2_v[i]))
        y_b = jnp.einsum('bsc,cd->bsd', o_b.astype(h.dtype), w_b[i])

        g_m = jax.nn.sigmoid(z_m.astype(jnp.float32)).reshape(B, S, 2, D)
        merged = (g_m[:, :, 0] * y_a + g_m[:, :, 1] * y_b).astype(h.dtype)
        h = h + jnp.einsum('bsd,de->bse', merged, w_out[i])

        h = h + peer_ffn(rmsnorm(h, norm_ffn[i]), peer_wq[i], peer_keys[i], peer_u[i], peer_v[i])

        gate = jax.nn.sigmoid(jnp.einsum('bsd,de->bse', rmsnorm(h, norm_ple[i]), ple_wg[i]).astype(jnp.float32))
        h = h + (gate * jnp.einsum('bsk,kd->bsd', p[i], ple_wp[i])).astype(h.dtype)
    return rmsnorm(h, norm_final)
```

```cpp
#include <hip/hip_runtime.h>
#include <hip/hip_cooperative_groups.h>
#include <cstdio>
#include <cstdint>
namespace cg = cooperative_groups;

#define LAS __attribute__((address_space(3)))
typedef unsigned short bf16_t;
typedef short bf16x8 __attribute__((ext_vector_type(8)));
typedef short s16x4 __attribute__((ext_vector_type(4)));
typedef float f32x2 __attribute__((ext_vector_type(2)));
typedef float f32x4 __attribute__((ext_vector_type(4)));
typedef float f32x16 __attribute__((ext_vector_type(16)));
typedef unsigned u32x2 __attribute__((ext_vector_type(2)));
typedef unsigned u32x4 __attribute__((ext_vector_type(4)));
typedef __bf16 bf16x2_t __attribute__((ext_vector_type(2)));
typedef unsigned u32x6 __attribute__((ext_vector_type(6)));
typedef float f32x32 __attribute__((ext_vector_type(32)));
typedef unsigned long long u64;

constexpr int NB = 8, S = 4096, T = NB * S, D = 1024, DIN = 6680, PLE = 256;
constexpr int NGRP = 2, HD = 128, NSELB = 64, NCMP = 255;
constexpr int NTHREADS = 512, NWAVES = 8;
constexpr float EPS = 1e-6f;
constexpr float LOG2E = 1.4426950408889634f;
constexpr float ATT_SCALE = 0.08838834764831845f;

constexpr size_t MiB = 1ull << 20;
constexpr size_t WS_CTL    = 0;
constexpr size_t WS_WIN_T  = 1 * MiB;
constexpr size_t WS_WA_T   = 11 * MiB;
constexpr size_t WS_WB_T   = 13 * MiB;
constexpr size_t WS_WM_T   = 15 * MiB;
constexpr size_t WS_WOUT_T = 19 * MiB;
constexpr size_t WS_WQ_T   = 21 * MiB;
constexpr size_t WS_WG_T   = 23 * MiB;
constexpr size_t WS_WP_T   = 25 * MiB;
constexpr size_t WS_W1K_T  = 26 * MiB;
constexpr size_t WS_W1V_T  = 28 * MiB;
constexpr size_t WS_LRUW   = 30 * MiB;
constexpr size_t WS_COS    = 31 * MiB;
constexpr size_t WS_SIN    = 39 * MiB;
constexpr size_t WS_C1P    = 47 * MiB;
constexpr size_t WS_PSCALE = 47 * MiB + 512 * 1024;
constexpr size_t WS_GATES  = 48 * MiB;
constexpr size_t WS_SEL    = 51 * MiB;
constexpr size_t WS_KC     = 52 * MiB;
constexpr size_t WS_W2T    = 54 * MiB;
constexpr size_t WS_R_XB   = 55 * MiB;
constexpr size_t WS_R_ZRX  = 119 * MiB;
constexpr size_t WS_R_GZ   = 183 * MiB;
constexpr size_t WS_R_Q    = 247 * MiB;
constexpr size_t WS_R_KV   = 311 * MiB;
constexpr size_t WS_R_OB   = 407 * MiB;
constexpr size_t WS_G12P   = WS_R_OB;
constexpr size_t WS_PB     = 496 * MiB;
constexpr size_t WS_SSQ    = 471 * MiB;
constexpr size_t WS_TAB    = 472 * MiB;
constexpr size_t WS_END    = 512 * MiB;

__device__ __forceinline__ unsigned cvt_pk_bf16(float lo, float hi) { unsigned r; asm("v_cvt_pk_bf16_f32 %0, %1, %2" : "=v"(r) : "v"(lo), "v"(hi)); return r; }
__device__ __forceinline__ float bf_lo(unsigned u) { return __uint_as_float(u << 16); }
__device__ __forceinline__ float bf_hi(unsigned u) { return __uint_as_float(u & 0xffff0000u); }
__device__ __forceinline__ float fast_exp2(float x) { return __builtin_amdgcn_exp2f(x); }
__device__ __forceinline__ float fast_rcp(float x) { return __builtin_amdgcn_rcpf(x); }
__device__ __forceinline__ float sigmoidf_(float x) { return fast_rcp(1.f + fast_exp2(-x * LOG2E)); }
__device__ __forceinline__ float gelu_tanh(float x) { const float y = 1.5957691216057308f * (x + 0.044715f * x * x * x); return x * fast_rcp(1.f + fast_exp2(-y * LOG2E)); }
__device__ __forceinline__ float wave_sum(float v) {
#pragma unroll
    for (int o = 1; o < 64; o <<= 1) v += __shfl_xor(v, o);
    return v;
}
constexpr int WID_LDS_OFF = 135168 + 256;
__device__ __forceinline__ int opaque_tid() {
    const unsigned slot = (unsigned)__builtin_amdgcn_s_getreg((5 << 11) | 4) & 0x3fu;
    const int w = __builtin_amdgcn_readfirstlane(((const volatile LAS int*)(uintptr_t)WID_LDS_OFF)[slot]);
    unsigned z = 0u; asm volatile("" : "+v"(z));
    int t = w * 64 + (int)__builtin_amdgcn_mbcnt_hi(~0u, __builtin_amdgcn_mbcnt_lo(~0u, z));
    asm volatile("" : "+v"(t)); return t; }
#define LDS_WAIT() asm volatile("s_waitcnt lgkmcnt(0)" ::: "memory")
#define VM_WAIT() asm volatile("s_waitcnt vmcnt(0)" ::: "memory")

struct Params {
    const float* in[34];
    float* out;
    unsigned char* ws;
};
enum { I_X = 0, I_P, I_POS, I_NORM_MIX, I_W_IN, I_CONV_W, I_CONV_B, I_LRU_WR, I_LRU_BR, I_LRU_WI, I_LRU_BI, I_LRU_LAM,
       I_PE_K, I_W1_K, I_B1_K, I_W2_K, I_B2_K, I_PE_V, I_W1_V, I_B1_V, I_W2_V, I_B2_V,
       I_W_A, I_W_B, I_W_OUT, I_NORM_FFN, I_PEER_WQ, I_PEER_KEYS, I_PEER_U, I_PEER_V, I_NORM_PLE, I_PLE_WG, I_PLE_WP, I_NORM_FINAL };
namespace pg8 {
#define PG8_LAS LAS
typedef short bf16x8 __attribute__((ext_vector_type(8)));
typedef float f32x4 __attribute__((ext_vector_type(4)));
typedef unsigned u32x4 __attribute__((ext_vector_type(4)));
constexpr int BM = 256, BK = 64, HALF = 128, HTB = HALF * BK * 2  , STAGE_BYTES = 8 * HTB, NXCD = 8, WGM = 8;

__host__ __device__ __forceinline__ int lds_byte(int r, int c) { const int st = (r >> 4) * 2 + (c >> 5), rr = r & 15, cc = c & 31, ob = rr * 64 + cc * 2; return st * 1024 + (ob ^ (((ob >> 9) & 1) << 5)); }
__host__ __device__ __forceinline__ void stage_rc(int b, int& R, int& C) { const int st = b / 1024, sb = b % 1024, swz = sb ^ (((sb >> 9) & 1) << 5); R = (st >> 1) * 16 + swz / 64; C = (st & 1) * 32 + (swz % 64) / 2; }
__host__ __device__ __forceinline__ int perm32(int rho) { const int n = rho >> 4, i = rho & 15; return 8 * (i >> 2) + 4 * n + (i & 3); }

struct Unit { int pm, pn; };
struct Gemm { const bf16_t* A; const bf16_t* Bt; int M, N, K; int lda = 0, ldb = 0; };

struct StaticOrder {
    int nM, nN, nwg, G, c;
    __host__ __device__ void init(int M, int N, int G_, int c_) { nM = M / BM; nN = N / BM; nwg = nM * nN; G = G_; c = c_; }
    __host__ __device__ bool next(int i, Unit& u) const {
        const long L = (long)i * G + c; if (L >= nwg) return false;
        int wgid = (int)L; { const int q = nwg / NXCD, r = nwg % NXCD, xcd = wgid % NXCD, off = wgid / NXCD; wgid = (xcd < r ? xcd * (q + 1) : r * (q + 1) + (xcd - r) * q) + off; }
        const int nig = WGM * nN, gid = wgid / nig, fm = gid * WGM, gsz = (nM - fm) < WGM ? (nM - fm) : WGM;
        u.pm = fm + ((wgid % nig) % gsz); u.pn = (wgid % nig) / gsz; return true;
    }
    __device__ __forceinline__ void a_ready(const Unit&) const {}
    __device__ __forceinline__ void done(const Unit&) const {}
};
template <class Epi, class Sched, bool ALIGN_EPI = false, bool SP2 = false>
__device__ __forceinline__ void gemm_phase(PG8_LAS unsigned char* lds, const Gemm g, const Sched& S, const Epi& E) {
    const int tid = opaque_tid(), wid = __builtin_amdgcn_readfirstlane(tid >> 6), lane = tid & 63, wr = wid >> 2, wc = wid & 3, fr = lane & 15, fq = lane >> 4;
    const int K = g.K, nt = K / BK, lda = g.lda ? g.lda : K, ldb = g.ldb ? g.ldb : K;
    unsigned voffA[2], voffB[2];
#pragma unroll
    for (int i = 0; i < 2; ++i) { int R, C; stage_rc(tid * 16 + i * 8192, R, C); const int Rb = Epi::PERM ? ((R & ~31) + perm32(R & 31)) : R;
        voffA[i] = (unsigned)(R * lda + C) * 2u; voffB[i] = (unsigned)(Rb * ldb + C) * 2u; }
    const size_t kstep = (size_t)(BK * 2);
    const size_t hA = (size_t)HALF * lda * 2, hB = (size_t)HALF * ldb * 2;
    const size_t tA = 2 * hA, tB = 2 * hB;
    const unsigned ldsw = (unsigned)wid * 1024u;
    const int aoff = lds_byte(wr * 64 + fr, fq * 8), boff = lds_byte(wc * 32 + fr, fq * 8);
#define PG8_SA(b, h) (((b) * 2 + (h)) * HTB)
#define PG8_SB(b, h) ((4 + (b) * 2 + (h)) * HTB)
#define PG8_STAGE(bufoff, gbase, voff) do { _Pragma("unroll") for (int _i = 0; _i < 2; ++_i) \
        __builtin_amdgcn_global_load_lds((const unsigned*)((const char*)(gbase) + (voff)[_i]), (PG8_LAS unsigned*)(lds + (bufoff) + ldsw + _i * 8192), 16, 0, 0); } while (0)
#define PG8_LDA(dst, b, h) do { _Pragma("unroll") for (int m = 0; m < 4; ++m) _Pragma("unroll") for (int k = 0; k < 2; ++k) dst[m][k] = *(const PG8_LAS bf16x8*)(lds + PG8_SA(b, h) + aoff + m * 2048 + k * 1024); } while (0)
#define PG8_LDB(dst, b, h) do { _Pragma("unroll") for (int n = 0; n < 2; ++n) _Pragma("unroll") for (int k = 0; k < 2; ++k) dst[n][k] = *(const PG8_LAS bf16x8*)(lds + PG8_SB(b, h) + boff + n * 2048 + k * 1024); } while (0)
#define PG8_MMA(ai, bj, At, Bt) do { __builtin_amdgcn_s_setprio(1); _Pragma("unroll") for (int m = 0; m < 4; ++m) _Pragma("unroll") for (int n = 0; n < 2; ++n) _Pragma("unroll") for (int k = 0; k < 2; ++k) \
        acc[ai][bj][m][n] = __builtin_amdgcn_mfma_f32_16x16x32_bf16(Bt[n][k], At[m][k], acc[ai][bj][m][n], 0, 0, 0); __builtin_amdgcn_s_setprio(0); } while (0)
#define PG8_WAIT_V(n) asm volatile("s_waitcnt vmcnt(" #n ")" ::: "memory")
#define PG8_WAIT_L(n) asm volatile("s_waitcnt lgkmcnt(" #n ")" ::: "memory")
#define PG8_BAR __builtin_amdgcn_s_barrier()
#define PG8_SCHED __builtin_amdgcn_sched_barrier(0)
    Unit cur, nxt; int ui = 0;
    if (!S.next(0, cur)) return;
    f32x4 acc[2][2][4][2];
#pragma unroll
    for (int a = 0; a < 2; ++a)
#pragma unroll
        for (int b = 0; b < 2; ++b)
#pragma unroll
            for (int m = 0; m < 4; ++m)
#pragma unroll
                for (int n = 0; n < 2; ++n) acc[a][b][m][n] = (f32x4){0.f, 0.f, 0.f, 0.f};
    bf16x8 At[4][2], B0[2][2], B1[2][2];
    const char* cA = (const char*)g.A + (size_t)cur.pm * tA; const char* cB = (const char*)g.Bt + (size_t)cur.pn * tB;
    S.a_ready(cur);
    if constexpr (SP2) {
        PG8_STAGE(PG8_SB(0, 0), cB, voffB); PG8_STAGE(PG8_SB(0, 1), cB + hB, voffB); PG8_STAGE(PG8_SA(0, 0), cA, voffA); PG8_STAGE(PG8_SA(0, 1), cA + hA, voffA);
        if (wr == 1) PG8_BAR;
        PG8_WAIT_V(2); PG8_BAR;
        PG8_STAGE(PG8_SB(1, 0), cB + kstep, voffB); PG8_STAGE(PG8_SA(1, 0), cA + kstep, voffA); PG8_STAGE(PG8_SB(1, 1), cB + hB + kstep, voffB);
        PG8_WAIT_V(6); PG8_BAR;
    } else {
        PG8_STAGE(PG8_SB(0, 0), cB, voffB); PG8_STAGE(PG8_SA(0, 0), cA, voffA); PG8_STAGE(PG8_SB(0, 1), cB + hB, voffB); PG8_STAGE(PG8_SA(0, 1), cA + hA, voffA);
        if (wr == 1) PG8_BAR;
        PG8_WAIT_V(4); PG8_BAR;
        PG8_STAGE(PG8_SB(1, 0), cB + kstep, voffB); PG8_STAGE(PG8_SA(1, 0), cA + kstep, voffA); PG8_STAGE(PG8_SB(1, 1), cB + hB + kstep, voffB);
        PG8_WAIT_V(6); PG8_BAR;
    }
    for (;;) {
        const bool has_next = S.next(ui + 1, nxt);
        const char* nA = has_next ? (const char*)g.A + (size_t)nxt.pm * tA : cA; const char* nB = has_next ? (const char*)g.Bt + (size_t)nxt.pn * tB : cB;
        for (int t = 0; t < nt; t += 2) {
            const bool last = (t == nt - 2);
            const char* a1 = cA + (size_t)(t + 1) * kstep;
            const char* a2 = last ? nA : cA + (size_t)(t + 2) * kstep; const char* b2 = last ? nB : cB + (size_t)(t + 2) * kstep;
            const char* a3 = a2 + kstep; const char* b3 = b2 + kstep;
            if (last && has_next) S.a_ready(nxt);
            if constexpr (SP2) {
            PG8_LDB(B0, 0, 0); PG8_LDB(B1, 0, 1); PG8_SCHED; PG8_LDA(At, 0, 0); PG8_STAGE(PG8_SA(1, 1), a1 + hA, voffA);
            PG8_WAIT_V(8); PG8_WAIT_L(0); PG8_BAR; PG8_MMA(0, 0, At, B0); PG8_MMA(0, 1, At, B1); PG8_BAR; PG8_SCHED;
            PG8_LDA(At, 0, 1); PG8_STAGE(PG8_SB(0, 0), b2, voffB); PG8_STAGE(PG8_SB(0, 1), b2 + hB, voffB); PG8_STAGE(PG8_SA(0, 0), a2, voffA);
            PG8_WAIT_V(8); PG8_WAIT_L(0); PG8_BAR; PG8_MMA(1, 0, At, B0); PG8_MMA(1, 1, At, B1); PG8_BAR; PG8_SCHED;
            PG8_LDB(B0, 1, 0); PG8_LDB(B1, 1, 1); PG8_SCHED; PG8_LDA(At, 1, 0); PG8_STAGE(PG8_SA(0, 1), a2 + hA, voffA);
            PG8_WAIT_V(8); PG8_WAIT_L(0); PG8_BAR; PG8_MMA(0, 0, At, B0); PG8_MMA(0, 1, At, B1); PG8_BAR; PG8_SCHED;
            PG8_LDA(At, 1, 1); PG8_STAGE(PG8_SB(1, 0), b3, voffB); PG8_STAGE(PG8_SB(1, 1), b3 + hB, voffB); PG8_STAGE(PG8_SA(1, 0), a3, voffA);
            PG8_WAIT_V(8); PG8_WAIT_L(0); PG8_BAR; PG8_MMA(1, 0, At, B0); PG8_MMA(1, 1, At, B1); PG8_BAR; PG8_SCHED;
            } else {
            PG8_LDB(B0, 0, 0); PG8_SCHED; PG8_LDA(At, 0, 0); PG8_STAGE(PG8_SA(1, 1), a1 + hA, voffA);
            PG8_WAIT_L(8); PG8_BAR; PG8_WAIT_L(0); PG8_MMA(0, 0, At, B0); PG8_BAR; PG8_SCHED;
            PG8_LDB(B1, 0, 1); PG8_STAGE(PG8_SB(0, 0), b2, voffB);
            PG8_BAR; PG8_WAIT_L(0); PG8_MMA(0, 1, At, B1); PG8_BAR;
            PG8_LDA(At, 0, 1); PG8_STAGE(PG8_SA(0, 0), a2, voffA);
            PG8_BAR; PG8_WAIT_L(0); PG8_MMA(1, 0, At, B0); PG8_BAR; PG8_SCHED;
            PG8_STAGE(PG8_SB(0, 1), b2 + hB, voffB);
            PG8_WAIT_V(6); PG8_BAR; PG8_MMA(1, 1, At, B1); PG8_BAR;
            PG8_LDB(B0, 1, 0); PG8_SCHED; PG8_LDA(At, 1, 0); PG8_STAGE(PG8_SA(0, 1), a2 + hA, voffA);
            PG8_WAIT_L(8); PG8_BAR; PG8_WAIT_L(0); PG8_MMA(0, 0, At, B0); PG8_BAR; PG8_SCHED;
            PG8_LDB(B1, 1, 1); PG8_STAGE(PG8_SB(1, 0), b3, voffB);
            PG8_BAR; PG8_WAIT_L(0); PG8_MMA(0, 1, At, B1); PG8_BAR;
            PG8_LDA(At, 1, 1); PG8_STAGE(PG8_SA(1, 0), a3, voffA);
            PG8_BAR; PG8_WAIT_L(0); PG8_MMA(1, 0, At, B0); PG8_BAR; PG8_SCHED;
            PG8_STAGE(PG8_SB(1, 1), b3 + hB, voffB);
            PG8_WAIT_V(6); PG8_BAR; PG8_MMA(1, 1, At, B1); PG8_BAR;
            }
        }
        if constexpr (ALIGN_EPI) { if (wr == 0) PG8_BAR; }
        if constexpr (!Epi::AFTER_DRAIN) { E(acc, cur, wr, wc, fr, fq); S.done(cur); }
        if (!has_next) break;
#pragma unroll
        for (int a = 0; a < 2; ++a)
#pragma unroll
            for (int b = 0; b < 2; ++b)
#pragma unroll
                for (int m = 0; m < 4; ++m)
#pragma unroll
                    for (int n = 0; n < 2; ++n) acc[a][b][m][n] = (f32x4){0.f, 0.f, 0.f, 0.f};
        cur = nxt; cA = nA; cB = nB; ++ui;
        if constexpr (ALIGN_EPI) { if (wr == 1) PG8_BAR; }
    }
    PG8_WAIT_V(0);
    if constexpr (!ALIGN_EPI) { if (wr == 0) PG8_BAR; }
    PG8_BAR;
    if constexpr (Epi::AFTER_DRAIN) { E.fused(acc, cur, wr, wc, fr, fq, lds, wid, lane); S.done(cur); }
#undef PG8_SA
#undef PG8_SB
#undef PG8_STAGE
#undef PG8_LDA
#undef PG8_LDB
#undef PG8_MMA
#undef PG8_WAIT_V
#undef PG8_WAIT_L
#undef PG8_BAR
#undef PG8_SCHED
}
}
using pg8::Unit;
__device__ __forceinline__ u32x4 pack8(f32x4 a, f32x4 b) { u32x4 w; w.x = cvt_pk_bf16(a[0], a[1]); w.y = cvt_pk_bf16(a[2], a[3]); w.z = cvt_pk_bf16(b[0], b[1]); w.w = cvt_pk_bf16(b[2], b[3]); return w; }

struct EpiBf {
    static constexpr bool PERM = true, AFTER_DRAIN = false;
    bf16_t* O; int ldc;
    __device__ __forceinline__ void operator()(const f32x4 (&acc)[2][2][4][2], const Unit& u, int wr, int wc, int fr, int fq) const {
        const int row0 = u.pm * 256 + wr * 64 + fr, col0 = u.pn * 256 + wc * 32 + 8 * fq;
#pragma unroll
        for (int ai = 0; ai < 2; ++ai)
#pragma unroll
            for (int m = 0; m < 4; ++m) { bf16_t* rowp = O + (size_t)(row0 + ai * 128 + m * 16) * ldc + col0;
#pragma unroll
                for (int bj = 0; bj < 2; ++bj) *(u32x4*)(rowp + bj * 128) = pack8(acc[ai][bj][m][0], acc[ai][bj][m][1]); }
    }
};

struct EpiZ {
    static constexpr bool PERM = true, AFTER_DRAIN = false;
    bf16_t *zrx, *gz, *q, *kv; float* gates;
    __device__ __forceinline__ void operator()(const f32x4 (&acc)[2][2][4][2], const Unit& u, int wr, int wc, int fr, int fq) const {
        const int pn = u.pn, row0 = u.pm * 256 + wr * 64 + fr, cl = wc * 32 + 8 * fq;
        if (pn < 12) {
            bf16_t* base = zrx + (size_t)(pn >> 2) * (size_t)(32u << 20);     const int colt = (pn & 3) * 256; const bool act = (pn >= 4 && pn < 8);
#pragma unroll
            for (int ai = 0; ai < 2; ++ai)
#pragma unroll
                for (int m = 0; m < 4; ++m) { bf16_t* rowp = base + (size_t)(row0 + ai * 128 + m * 16) * 1024 + colt + cl;
#pragma unroll
                    for (int bj = 0; bj < 2; ++bj) { f32x4 v0 = acc[ai][bj][m][0], v1 = acc[ai][bj][m][1];
                        if (act) {
#pragma unroll
                            for (int e = 0; e < 4; ++e) { v0[e] = gelu_tanh(v0[e]); v1[e] = gelu_tanh(v1[e]); } }
                        *(u32x4*)(rowp + bj * 128) = pack8(v0, v1); } }
        } else if (pn < 18) {
            const int j = pn - 12, b = u.pm >> 4, tb = (u.pm & 15) * 256 + wr * 64 + fr;
#pragma unroll
            for (int ai = 0; ai < 2; ++ai)
#pragma unroll
                for (int m = 0; m < 4; ++m) { const int t = tb + ai * 128 + m * 16;
#pragma unroll
                    for (int bj = 0; bj < 2; ++bj) { bf16_t* dst = kv + ((size_t)((j * 8 + b) * 2 + bj) * S + t) * 128 + cl;
                        *(u32x4*)dst = pack8(acc[ai][bj][m][0], acc[ai][bj][m][1]); } }
        } else {
            if (wc == 0 && fq < 3) {
#pragma unroll
                for (int ai = 0; ai < 2; ++ai)
#pragma unroll
                    for (int m = 0; m < 4; ++m) { float* dst = gates + (size_t)(row0 + ai * 128 + m * 16) * 24 + 8 * fq;
                        f32x4 v0 = acc[ai][0][m][0], v1 = acc[ai][0][m][1];
#pragma unroll
                        for (int e = 0; e < 4; ++e) { v0[e] = sigmoidf_(v0[e]); v1[e] = sigmoidf_(v1[e]); }
                        *(f32x4*)dst = v0; *(f32x4*)(dst + 4) = v1; }
            }
        }
    }
};

static_assert(WS_R_GZ - WS_R_ZRX == 64 * MiB && WS_R_Q - WS_R_GZ == 64 * MiB, "EpiZ region spacing");
struct EpiMerge {
    static constexpr bool PERM = true, AFTER_DRAIN = false;
    const bf16_t* ya; const bf16_t* yb; bf16_t* out;
    __device__ __forceinline__ void operator()(const f32x4 (&acc)[2][2][4][2], const Unit& u, int wr, int wc, int fr, int fq) const {
        const int row0 = u.pm * 256 + wr * 64 + fr, d0 = u.pn * 128 + wc * 32 + 8 * fq;
#pragma unroll
        for (int ai = 0; ai < 2; ++ai)
#pragma unroll
            for (int m = 0; m < 4; ++m) { const size_t off = (size_t)(row0 + ai * 128 + m * 16) * 1024 + d0;
                const u32x4 a = *(const u32x4*)(ya + off), b = *(const u32x4*)(yb + off);
                f32x4 o0, o1;
#pragma unroll
                for (int e = 0; e < 2; ++e) {
                    o0[2 * e]     = sigmoidf_(acc[ai][0][m][0][2 * e])     * bf_lo(a[e])     + sigmoidf_(acc[ai][1][m][0][2 * e])     * bf_lo(b[e]);
                    o0[2 * e + 1] = sigmoidf_(acc[ai][0][m][0][2 * e + 1]) * bf_hi(a[e])     + sigmoidf_(acc[ai][1][m][0][2 * e + 1]) * bf_hi(b[e]);
                    o1[2 * e]     = sigmoidf_(acc[ai][0][m][1][2 * e])     * bf_lo(a[2 + e]) + sigmoidf_(acc[ai][1][m][1][2 * e])     * bf_lo(b[2 + e]);
                    o1[2 * e + 1] = sigmoidf_(acc[ai][0][m][1][2 * e + 1]) * bf_hi(a[2 + e]) + sigmoidf_(acc[ai][1][m][1][2 * e + 1]) * bf_hi(b[2 + e]); }
                *(u32x4*)(out + off) = pack8(o0, o1); }
    }
};

struct EpiResid {
    static constexpr bool PERM = true, AFTER_DRAIN = false;
    const float* x; float* out;
    __device__ __forceinline__ void operator()(const f32x4 (&acc)[2][2][4][2], const Unit& u, int wr, int wc, int fr, int fq) const {
        const int row0 = u.pm * 256 + wr * 64 + fr, col0 = u.pn * 256 + wc * 32 + 8 * fq;
#pragma unroll
        for (int ai = 0; ai < 2; ++ai)
#pragma unroll
            for (int m = 0; m < 4; ++m)
#pragma unroll
                for (int bj = 0; bj < 2; ++bj) { const size_t off = (size_t)(row0 + ai * 128 + m * 16) * 1024 + col0 + bj * 128;
                    const f32x4 x0 = *(const f32x4*)(x + off), x1 = *(const f32x4*)(x + off + 4);
                    *(f32x4*)(out + off) = x0 + acc[ai][bj][m][0]; *(f32x4*)(out + off + 4) = x1 + acc[ai][bj][m][1]; }
    }
};

struct EpiPle {
    static constexpr bool PERM = true, AFTER_DRAIN = false;
    float* h; const bf16_t* pp;
    __device__ __forceinline__ void operator()(const f32x4 (&acc)[2][2][4][2], const Unit& u, int wr, int wc, int fr, int fq) const {
        const int row0 = u.pm * 256 + wr * 64 + fr, col0 = u.pn * 256 + wc * 32 + 8 * fq;
#pragma unroll
        for (int ai = 0; ai < 2; ++ai)
#pragma unroll
            for (int m = 0; m < 4; ++m)
#pragma unroll
                for (int bj = 0; bj < 2; ++bj) { const size_t off = (size_t)(row0 + ai * 128 + m * 16) * 1024 + col0 + bj * 128;
                    f32x4 h0 = *(const f32x4*)(h + off), h1 = *(const f32x4*)(h + off + 4); const u32x4 pv = *(const u32x4*)(pp + off);
                    const f32x4 a0 = acc[ai][bj][m][0], a1 = acc[ai][bj][m][1];
                    h0[0] += sigmoidf_(a0[0]) * bf_lo(pv[0]); h0[1] += sigmoidf_(a0[1]) * bf_hi(pv[0]); h0[2] += sigmoidf_(a0[2]) * bf_lo(pv[1]); h0[3] += sigmoidf_(a0[3]) * bf_hi(pv[1]);
                    h1[0] += sigmoidf_(a1[0]) * bf_lo(pv[2]); h1[1] += sigmoidf_(a1[1]) * bf_hi(pv[2]); h1[2] += sigmoidf_(a1[2]) * bf_lo(pv[3]); h1[3] += sigmoidf_(a1[3]) * bf_hi(pv[3]);
                    *(f32x4*)(h + off) = h0; *(f32x4*)(h + off + 4) = h1; }
    }
};

#define PN_CNT(pm) (4096 + 64 * (pm))
constexpr int PN_PT_OFF = 131072, PN_SR_OFF = 135168 + 512;
struct EpiPleNorm {
    static constexpr bool PERM = true, AFTER_DRAIN = false;
    float* h; const bf16_t* pp; const float* g; unsigned* slots; unsigned* ctl; LAS unsigned char* lds; unsigned want;
    __device__ __forceinline__ void operator()(const f32x4 (&acc_)[2][2][4][2], const Unit& u, int wr, int wc, int fr, int fq) const {
        f32x4 (&acc)[2][2][4][2] = const_cast<f32x4 (&)[2][2][4][2]>(acc_);
        const int wid = wr * 4 + wc, lane = fq * 16 + fr;
        const int row0 = u.pm * 256 + wr * 64 + fr, col0 = u.pn * 256 + wc * 32 + 8 * fq;
        LAS float* Pt = (LAS float*)(lds + PN_PT_OFF);
        LAS float* Sr = (LAS float*)(lds + PN_SR_OFF);
#pragma unroll
        for (int ai = 0; ai < 2; ++ai)
#pragma unroll
            for (int m = 0; m < 4; ++m) { float ss = 0.f;
#pragma unroll
                for (int bj = 0; bj < 2; ++bj) { const size_t off = (size_t)(row0 + ai * 128 + m * 16) * 1024 + col0 + bj * 128;
                    f32x4 h0 = *(const f32x4*)(h + off), h1 = *(const f32x4*)(h + off + 4); const u32x4 pv = *(const u32x4*)(pp + off);
                    const f32x4 a0 = acc[ai][bj][m][0], a1 = acc[ai][bj][m][1];
                    h0[0] += sigmoidf_(a0[0]) * bf_lo(pv[0]); h0[1] += sigmoidf_(a0[1]) * bf_hi(pv[0]); h0[2] += sigmoidf_(a0[2]) * bf_lo(pv[1]); h0[3] += sigmoidf_(a0[3]) * bf_hi(pv[1]);
                    h1[0] += sigmoidf_(a1[0]) * bf_lo(pv[2]); h1[1] += sigmoidf_(a1[1]) * bf_hi(pv[2]); h1[2] += sigmoidf_(a1[2]) * bf_lo(pv[3]); h1[3] += sigmoidf_(a1[3]) * bf_hi(pv[3]);
                    acc[ai][bj][m][0] = h0; acc[ai][bj][m][1] = h1;
                    ss += (h0[0] * h0[0] + h0[1] * h0[1]) + (h0[2] * h0[2] + h0[3] * h0[3]) + (h1[0] * h1[0] + h1[1] * h1[1]) + (h1[2] * h1[2] + h1[3] * h1[3]); }
                ss += __shfl_xor(ss, 16); ss += __shfl_xor(ss, 32);
                if (fq == 0) Pt[(ai * 128 + wr * 64 + m * 16 + fr) * 4 + wc] = ss; }
        asm volatile("s_waitcnt lgkmcnt(0)" ::: "memory"); __builtin_amdgcn_s_barrier(); asm volatile("" ::: "memory");
        const int row = wid * 32 + (lane & 31);
        if (lane < 32) { const f32x4 p = *(const LAS f32x4*)(Pt + row * 4);
            __hip_atomic_store(slots + (size_t)(u.pm * 256 + row) * 4 + u.pn, __float_as_uint((p[0] + p[1]) + (p[2] + p[3])), __ATOMIC_RELAXED, __HIP_MEMORY_SCOPE_AGENT); }
        asm volatile("s_waitcnt vmcnt(0)" ::: "memory");
        if (lane == 0) __hip_atomic_fetch_add(ctl + PN_CNT(u.pm), 1u, __ATOMIC_RELAXED, __HIP_MEMORY_SCOPE_AGENT);
        if (wid == 0) {
            unsigned sp = 0u;
            while ((unsigned)__builtin_amdgcn_readfirstlane(__hip_atomic_load(ctl + PN_CNT(u.pm), __ATOMIC_RELAXED, __HIP_MEMORY_SCOPE_AGENT)) < want) { __builtin_amdgcn_s_sleep(2); if (++sp > (1u << 20)) break; }
            __builtin_amdgcn_fence(__ATOMIC_ACQUIRE, "agent");
        }
        asm volatile("s_waitcnt vmcnt(0) lgkmcnt(0)" ::: "memory"); __builtin_amdgcn_s_barrier(); asm volatile("" ::: "memory");
        if (lane < 32) { const unsigned* sl = slots + (size_t)(u.pm * 256 + row) * 4; float s = 0.f;
#pragma unroll
            for (int t = 0; t < 4; ++t) s += __uint_as_float(__hip_atomic_load(sl + t, __ATOMIC_RELAXED, __HIP_MEMORY_SCOPE_AGENT));
            Sr[row] = 1.0f / sqrtf(s * (1.0f / 1024.0f) + EPS); }
        asm volatile("s_waitcnt lgkmcnt(0)" ::: "memory"); __builtin_amdgcn_s_barrier(); asm volatile("" ::: "memory");
        const f32x4 ga0 = *(const f32x4*)(g + col0), ga1 = *(const f32x4*)(g + col0 + 4), gb0 = *(const f32x4*)(g + col0 + 128), gb1 = *(const f32x4*)(g + col0 + 132);
#pragma unroll
        for (int ai = 0; ai < 2; ++ai)
#pragma unroll
            for (int m = 0; m < 4; ++m) { const float rs = Sr[ai * 128 + wr * 64 + m * 16 + fr];
#pragma unroll
                for (int bj = 0; bj < 2; ++bj) { const size_t off = (size_t)(row0 + ai * 128 + m * 16) * 1024 + col0 + bj * 128;
                    *(f32x4*)(h + off) = acc[ai][bj][m][0] * rs * (bj ? gb0 : ga0); *(f32x4*)(h + off + 4) = acc[ai][bj][m][1] * rs * (bj ? gb1 : ga1); } }
    }
};
struct EpiResidNorm {
    static constexpr bool PERM = true, AFTER_DRAIN = false;
    const float* x; float* h; bf16_t* xn; const float* g; unsigned* slots; unsigned* ctl; LAS unsigned char* lds; unsigned want;
    __device__ __forceinline__ void operator()(const f32x4 (&acc_)[2][2][4][2], const Unit& u, int wr, int wc, int fr, int fq) const {
        f32x4 (&acc)[2][2][4][2] = const_cast<f32x4 (&)[2][2][4][2]>(acc_);
        const int wid = wr * 4 + wc, lane = fq * 16 + fr;
        const int row0 = u.pm * 256 + wr * 64 + fr, col0 = u.pn * 256 + wc * 32 + 8 * fq;
        LAS float* Pt = (LAS float*)(lds + PN_PT_OFF);
        LAS float* Sr = (LAS float*)(lds + PN_SR_OFF);
#pragma unroll
        for (int ai = 0; ai < 2; ++ai)
#pragma unroll
            for (int m = 0; m < 4; ++m) { float ss = 0.f;
#pragma unroll
                for (int bj = 0; bj < 2; ++bj) { const size_t off = (size_t)(row0 + ai * 128 + m * 16) * 1024 + col0 + bj * 128;
                    const f32x4 h0 = *(const f32x4*)(x + off) + acc[ai][bj][m][0], h1 = *(const f32x4*)(x + off + 4) + acc[ai][bj][m][1];
                    *(f32x4*)(h + off) = h0; *(f32x4*)(h + off + 4) = h1;
                    acc[ai][bj][m][0] = h0; acc[ai][bj][m][1] = h1;
                    ss += (h0[0] * h0[0] + h0[1] * h0[1]) + (h0[2] * h0[2] + h0[3] * h0[3]) + (h1[0] * h1[0] + h1[1] * h1[1]) + (h1[2] * h1[2] + h1[3] * h1[3]); }
                ss += __shfl_xor(ss, 16); ss += __shfl_xor(ss, 32);
                if (fq == 0) Pt[(ai * 128 + wr * 64 + m * 16 + fr) * 4 + wc] = ss; }
        asm volatile("s_waitcnt lgkmcnt(0)" ::: "memory"); __builtin_amdgcn_s_barrier(); asm volatile("" ::: "memory");
        const int row = wid * 32 + (lane & 31);
        if (lane < 32) { const f32x4 p = *(const LAS f32x4*)(Pt + row * 4);
            __hip_atomic_store(slots + (size_t)(u.pm * 256 + row) * 4 + u.pn, __float_as_uint((p[0] + p[1]) + (p[2] + p[3])), __ATOMIC_RELAXED, __HIP_MEMORY_SCOPE_AGENT); }
        asm volatile("s_waitcnt vmcnt(0)" ::: "memory");
        if (lane == 0) __hip_atomic_fetch_add(ctl + PN_CNT(u.pm), 1u, __ATOMIC_RELAXED, __HIP_MEMORY_SCOPE_AGENT);
        if (wid == 0) {
            unsigned sp = 0u;
            while ((unsigned)__builtin_amdgcn_readfirstlane(__hip_atomic_load(ctl + PN_CNT(u.pm), __ATOMIC_RELAXED, __HIP_MEMORY_SCOPE_AGENT)) < want) { __builtin_amdgcn_s_sleep(2); if (++sp > (1u << 20)) break; }
            __builtin_amdgcn_fence(__ATOMIC_ACQUIRE, "agent");
        }
        asm volatile("s_waitcnt vmcnt(0) lgkmcnt(0)" ::: "memory"); __builtin_amdgcn_s_barrier(); asm volatile("" ::: "memory");
        if (lane < 32) { const unsigned* sl = slots + (size_t)(u.pm * 256 + row) * 4; float s = 0.f;
#pragma unroll
            for (int t = 0; t < 4; ++t) s += __uint_as_float(__hip_atomic_load(sl + t, __ATOMIC_RELAXED, __HIP_MEMORY_SCOPE_AGENT));
            Sr[row] = 1.0f / sqrtf(s * (1.0f / 1024.0f) + EPS); }
        asm volatile("s_waitcnt lgkmcnt(0)" ::: "memory"); __builtin_amdgcn_s_barrier(); asm volatile("" ::: "memory");
        const f32x4 ga0 = *(const f32x4*)(g + col0), ga1 = *(const f32x4*)(g + col0 + 4), gb0 = *(const f32x4*)(g + col0 + 128), gb1 = *(const f32x4*)(g + col0 + 132);
#pragma unroll
        for (int ai = 0; ai < 2; ++ai)
#pragma unroll
            for (int m = 0; m < 4; ++m) { const float rs = Sr[ai * 128 + wr * 64 + m * 16 + fr];
#pragma unroll
                for (int bj = 0; bj < 2; ++bj) { const size_t off = (size_t)(row0 + ai * 128 + m * 16) * 1024 + col0 + bj * 128;
                    *(u32x4*)(xn + off) = pack8(acc[ai][bj][m][0] * rs * (bj ? gb0 : ga0), acc[ai][bj][m][1] * rs * (bj ? gb1 : ga1)); } }
    }
};
struct PanelOrder {
    int pm, pn, dpm, n;
    __device__ __forceinline__ bool next(int i, Unit& u) const { if (i >= n) return false; u.pm = pm + i * dpm; u.pn = pn; return true; }
    __device__ __forceinline__ void a_ready(const Unit&) const {}
    __device__ __forceinline__ void done(const Unit&) const {}
};

struct RangeOrder {
    int nN, first, count, nblk, me;
    __device__ __forceinline__ bool next(int i, Unit& u) const {
        if (me < 0) return false; const int L = i * nblk + me; if (L >= count) return false;
        const int idx = first + L; u.pm = idx / nN; u.pn = idx % nN; return true;
    }
    __device__ __forceinline__ void a_ready(const Unit&) const {}
    __device__ __forceinline__ void done(const Unit&) const {}
};
__device__ __forceinline__ void transpose_item(const float* __restrict__ W, int ldw, int nvalid, bf16_t* WT, int ldt, LAS float* scr, int kb, int nb, int lane) {
    const int k0 = 64 * kb, n0 = 32 * nb, nn = n0 + (lane & 31); const bool ok = nn < nvalid;
#pragma unroll 8
    for (int i = 0; i < 32; ++i) { const int kk = 2 * i + (lane >> 5); scr[kk * 33 + (lane & 31)] = ok ? W[(size_t)(k0 + kk) * ldw + nn] : 0.f; }
    LDS_WAIT(); asm volatile("" ::: "memory");
    const int c = lane & 7;
#pragma unroll
    for (int j = 0; j < 4; ++j) { const int n = (lane >> 3) + 8 * j; const LAS float* s = scr + (8 * c) * 33 + n;
        u32x4 o; o.x = cvt_pk_bf16(s[0 * 33], s[1 * 33]); o.y = cvt_pk_bf16(s[2 * 33], s[3 * 33]); o.z = cvt_pk_bf16(s[4 * 33], s[5 * 33]); o.w = cvt_pk_bf16(s[6 * 33], s[7 * 33]);
        *(u32x4*)(WT + (size_t)(n0 + n) * ldt + k0 + 8 * c) = o; }
    LDS_WAIT(); asm volatile("" ::: "memory");
}
__device__ __forceinline__ void rms_row(const float* xrow, const float* g, bf16_t* obf, float* of32, int lane) {
    f32x4 v[4]; float s = 0.f;
#pragma unroll
    for (int j = 0; j < 4; ++j) { v[j] = ((const f32x4*)xrow)[lane + 64 * j]; s += (v[j][0] * v[j][0] + v[j][1] * v[j][1]) + (v[j][2] * v[j][2] + v[j][3] * v[j][3]); }
    s = wave_sum(s);
    const float rs = 1.0f / sqrtf(s * (1.0f / 1024.0f) + EPS);
#pragma unroll
    for (int j = 0; j < 4; ++j) { const f32x4 gv = ((const f32x4*)g)[lane + 64 * j]; const f32x4 o = v[j] * rs * gv;
        if (obf) { u32x2 w; w.x = cvt_pk_bf16(o[0], o[1]); w.y = cvt_pk_bf16(o[2], o[3]); ((u32x2*)obf)[lane + 64 * j] = w; }
        else ((f32x4*)of32)[lane + 64 * j] = o; }
}

__device__ __forceinline__ void rms_rows2(const float* x0, const float* x1, const float* g, bf16_t* o0, bf16_t* o1, float* f0, float* f1, int lane) {
    f32x4 v[2][4]; float s0 = 0.f, s1 = 0.f;
#pragma unroll
    for (int j = 0; j < 4; ++j) { v[0][j] = ((const f32x4*)x0)[lane + 64 * j]; v[1][j] = ((const f32x4*)x1)[lane + 64 * j]; }
#pragma unroll
    for (int j = 0; j < 4; ++j) { s0 += (v[0][j][0] * v[0][j][0] + v[0][j][1] * v[0][j][1]) + (v[0][j][2] * v[0][j][2] + v[0][j][3] * v[0][j][3]);
                                  s1 += (v[1][j][0] * v[1][j][0] + v[1][j][1] * v[1][j][1]) + (v[1][j][2] * v[1][j][2] + v[1][j][3] * v[1][j][3]); }
#pragma unroll
    for (int o = 1; o < 64; o <<= 1) { s0 += __shfl_xor(s0, o); s1 += __shfl_xor(s1, o); }
    const float r0 = 1.0f / sqrtf(s0 * (1.0f / 1024.0f) + EPS), r1 = 1.0f / sqrtf(s1 * (1.0f / 1024.0f) + EPS);
#pragma unroll
    for (int j = 0; j < 4; ++j) { const f32x4 gv = ((const f32x4*)g)[lane + 64 * j]; const f32x4 a = v[0][j] * r0 * gv, b = v[1][j] * r1 * gv;
        if (o0) { u32x2 w; w.x = cvt_pk_bf16(a[0], a[1]); w.y = cvt_pk_bf16(a[2], a[3]); ((u32x2*)o0)[lane + 64 * j] = w; w.x = cvt_pk_bf16(b[0], b[1]); w.y = cvt_pk_bf16(b[2], b[3]); ((u32x2*)o1)[lane + 64 * j] = w; }
        else { ((f32x4*)f0)[lane + 64 * j] = a; ((f32x4*)f1)[lane + 64 * j] = b; } }
}
__device__ __forceinline__ void phase0(const Params& P, unsigned char* lds_raw) {
    const int tid = opaque_tid(), lane = tid & 63, wave = __builtin_amdgcn_readfirstlane(tid >> 6);
    const int gw = blockIdx.x * NWAVES + wave, NGW = gridDim.x * NWAVES;
    unsigned char* ws = P.ws;
    LAS float* scr = (LAS float*)((LAS unsigned char*)lds_raw + wave * 16384);
    if (blockIdx.x & 1) for (int m = 2 * gw; m < T; m += 2 * NGW) rms_rows2(P.in[I_X] + (size_t)m * D, P.in[I_X] + (size_t)(m + 1) * D, P.in[I_NORM_MIX], (bf16_t*)(ws + WS_R_XB) + (size_t)m * D, (bf16_t*)(ws + WS_R_XB) + (size_t)(m + 1) * D, nullptr, nullptr, lane);
    constexpr int N_WIN = 16 * 152, N_W1 = 1024, N_LRU = 128, N_ITEMS = N_WIN + N_W1 + N_LRU;
    for (int it = gw; it < N_ITEMS; it += NGW) {
        int r = it;
        if (r < N_WIN) { transpose_item(P.in[I_W_IN], DIN, 4632, (bf16_t*)(ws + WS_WIN_T), 1024, scr, r / 152, r % 152, lane); continue; } r -= N_WIN;
        if (r < N_W1) { const int which = r >> 9, rr = r & 511, half = rr >> 8, r2 = rr & 255;
            const float* src = (which ? P.in[I_W1_V] : P.in[I_W1_K]) + (size_t)half * 2048 * 256;
            bf16_t* dst = (bf16_t*)(ws + (which ? WS_W1V_T : WS_W1K_T)) + (size_t)half * 256 * 2048;
            transpose_item(src, 256, 256, dst, 2048, scr, r2 >> 3, r2 & 7, lane); continue; } r -= N_W1;
        { const int sub = r >> 3, rr = r & 7, n = sub >> 1, gate = sub & 1;
            const float* src = (gate ? P.in[I_LRU_WI] : P.in[I_LRU_WR]) + (size_t)n * 16384;
            transpose_item(src, 128, 128, (bf16_t*)(ws + WS_LRUW) + (size_t)(n * 256 + gate * 128) * 128, 128, scr, rr >> 2, rr & 3, lane); }
    }
    if (!(blockIdx.x & 1)) for (int m = 2 * gw; m < T; m += 2 * NGW) rms_rows2(P.in[I_X] + (size_t)m * D, P.in[I_X] + (size_t)(m + 1) * D, P.in[I_NORM_MIX], (bf16_t*)(ws + WS_R_XB) + (size_t)m * D, (bf16_t*)(ws + WS_R_XB) + (size_t)(m + 1) * D, nullptr, nullptr, lane);
    { const int gt = blockIdx.x * NTHREADS + tid, NGT = gridDim.x * NTHREADS;
      const int* pos = (const int*)P.in[I_POS]; float* ct = (float*)(ws + WS_COS); float* st = (float*)(ws + WS_SIN);
      for (int i = gt; i < T * 64; i += NGT) { const int t = i >> 6, f = i & 63;
          const float inv = exp2f(-(float)f * (13.287712379549449f / 64.0f));
          const float ang = (float)pos[t] * inv;
          const double rev = (double)ang * 0.15915494309189535; const float fr = (float)(rev - rint(rev));
          ct[i] = __builtin_amdgcn_cosf(fr); st[i] = __builtin_amdgcn_sinf(fr); } }
}
__device__ __forceinline__ void side_work(const Params& P, unsigned char* lds_raw, int sw, int nsw) {
    const int tid = opaque_tid(), lane = tid & 63, wave = __builtin_amdgcn_readfirstlane(tid >> 6);
    unsigned char* ws = P.ws;
    LAS float* scr = (LAS float*)((LAS unsigned char*)lds_raw + wave * 16384);
    constexpr int N_WM = 1024, N_SQ = 5 * 512, N_WP = 128, N_W2 = 32, N_ITEMS = N_WM + N_SQ + N_WP + N_W2;
    for (int it = sw; it < N_ITEMS; it += nsw) {
        int r = it;
        if (r < N_WM) { const int sub = r >> 6, rr = r & 63, pn = sub >> 1, half = sub & 1;
            transpose_item(P.in[I_W_IN] + 4632 + half * 1024 + 128 * pn, DIN, 128, (bf16_t*)(ws + WS_WM_T) + (size_t)(256 * pn + 128 * half) * 1024, 1024, scr, rr >> 2, rr & 3, lane); continue; } r -= N_WM;
        if (r < N_SQ) { const int which = r >> 9, rr = r & 511;
            const float* src = which == 0 ? P.in[I_W_A] : which == 1 ? P.in[I_W_B] : which == 2 ? P.in[I_W_OUT] : which == 3 ? P.in[I_PEER_WQ] : P.in[I_PLE_WG];
            const size_t dof = which == 0 ? WS_WA_T : which == 1 ? WS_WB_T : which == 2 ? WS_WOUT_T : which == 3 ? WS_WQ_T : WS_WG_T;
            transpose_item(src, 1024, 1024, (bf16_t*)(ws + dof), 1024, scr, rr >> 5, rr & 31, lane); continue; } r -= N_SQ;
        if (r < N_WP) { transpose_item(P.in[I_PLE_WP], 1024, 1024, (bf16_t*)(ws + WS_WP_T), 256, scr, r >> 5, r & 31, lane); continue; } r -= N_WP;
        { const int j = r >> 4, rr = r & 15; transpose_item(P.in[j ? I_W2_V : I_W2_K], 128, 128, (bf16_t*)(ws + WS_W2T) + (size_t)j * 128 * 256, 256, scr, rr >> 2, rr & 3, lane); }
    }
    for (int it = sw; it < 128; it += nsw) { const int j = it >> 6, chunk = it & 63; const float* pe = P.in[j ? I_PE_V : I_PE_K]; const float* w1 = P.in[j ? I_W1_V : I_W1_K];
        f32x4 a = {0.f, 0.f, 0.f, 0.f};
#pragma unroll 16
        for (int f = chunk * 64; f < chunk * 64 + 64; ++f) { const float pv = pe[f]; const f32x4 w = ((const f32x4*)(w1 + (size_t)f * 256))[lane]; a += w * pv; }
        ((f32x4*)((float*)(ws + WS_C1P) + (size_t)(j * 64 + chunk) * 256))[lane] = a; }
}
constexpr int LRU_A = 0, LRU_XA = 65536, LRU_BW = 98304, LRU_WS = 114688, LRU_END = LRU_WS + 4096;
__device__ __forceinline__ void lru_unit(const Params& P, unsigned char* lds_raw, int b, int slab) {
    LAS unsigned char* lds = (LAS unsigned char*)lds_raw;
    const int tid = opaque_tid();
    const int lane = tid & 63, wave = __builtin_amdgcn_readfirstlane(tid >> 6);
    unsigned char* ws = P.ws;
    const int nblk = slab >> 2, sl = slab & 3;
    const bf16_t* zrx = (const bf16_t*)(ws + WS_R_ZRX) + (size_t)b * S * 1024 + 128 * nblk;
    bf16_t* gz = (bf16_t*)(ws + WS_R_GZ) + (size_t)b * S * 1024 + slab * 32;
    const int cg = tid & 15, tg = tid >> 4;
    { const bf16_t* lw = (const bf16_t*)(ws + WS_LRUW) + (size_t)nblk * 256 * 128;
#pragma unroll
      for (int e = 0; e < 2; ++e) { const int idx = tid + 512 * e, row = idx >> 4, ch = idx & 15, srow = (row >> 5) * 128 + sl * 32 + 2 * (row & 15) + ((row >> 4) & 1);
          *(LAS u32x4*)(lds + LRU_BW + row * 256 + ((ch ^ (row & 15)) << 4)) = *(const u32x4*)(lw + (size_t)srow * 128 + ch * 8); } }
    const int cc = lane & 15, grp = lane >> 4;
    float br_[2], bi_[2], sp8[2];
#pragma unroll
    for (int p = 0; p < 2; ++p) { const int c = slab * 32 + 2 * cc + p;
        br_[p] = P.in[I_LRU_BR][c]; bi_[p] = P.in[I_LRU_BI][c]; sp8[p] = 8.0f * log1pf(expf(-P.in[I_LRU_LAM][c])); }
    float hin[2] = {0.f, 0.f};
    float cw[4][8], cb[8];
    { const float* w = P.in[I_CONV_W] + 128 * nblk + 8 * cg; const float* bb = P.in[I_CONV_B] + 128 * nblk + 8 * cg;
#pragma unroll
      for (int k = 0; k < 4; ++k) { const f32x4 a = *(const f32x4*)(w + k * 1024), c = *(const f32x4*)(w + k * 1024 + 4);
#pragma unroll
          for (int e = 0; e < 4; ++e) { cw[k][e] = a[e]; cw[k][4 + e] = c[e]; } }
      const f32x4 a = *(const f32x4*)bb, c = *(const f32x4*)(bb + 4);
#pragma unroll
      for (int e = 0; e < 4; ++e) { cb[e] = a[e]; cb[4 + e] = c[e]; } }
    u32x4 rows[7]; unsigned gzp[4];
    const int tk0 = 16 * wave + 4 * grp;
#pragma unroll
    for (int i = 0; i < 7; ++i) { const int tr = 4 * tg - 3 + i; rows[i] = tr >= 0 ? *(const u32x4*)(zrx + (size_t)tr * 1024 + 8 * cg) : (u32x4){0u, 0u, 0u, 0u}; }
#pragma unroll
    for (int r = 0; r < 4; ++r) gzp[r] = *(const unsigned*)(gz + (size_t)(tk0 + r) * 1024 + 2 * cc);
#define LRU_CONV(CT) do { const int ct = (CT); LAS unsigned char* Ac = lds + LRU_A + (ct & 1) * 32768; LAS float* XAc = (LAS float*)(lds + LRU_XA + (ct & 1) * 16384); \
        { \
            float x[7][8]; \
_Pragma("unroll") \
            for (int i = 0; i < 7; ++i) \
_Pragma("unroll") \
                for (int e = 0; e < 4; ++e) { x[i][2 * e] = bf_lo(rows[i][e]); x[i][2 * e + 1] = bf_hi(rows[i][e]); } \
_Pragma("unroll") \
            for (int i = 0; i < 4; ++i) { float y[8]; \
_Pragma("unroll") \
                for (int e = 0; e < 8; ++e) y[e] = cb[e] + cw[0][e] * x[i][e] + cw[1][e] * x[i + 1][e] + cw[2][e] * x[i + 2][e] + cw[3][e] * x[i + 3][e]; \
                const int row = 4 * tg + i; \
                u32x4 w; w.x = cvt_pk_bf16(y[0], y[1]); w.y = cvt_pk_bf16(y[2], y[3]); w.z = cvt_pk_bf16(y[4], y[5]); w.w = cvt_pk_bf16(y[6], y[7]); \
                *(LAS u32x4*)(Ac + row * 256 + ((cg ^ (row & 15)) << 4)) = w; \
                if ((cg >> 2) == sl) { LAS float* xp = XAc + row * 32 + (cg & 3) * 8; \
                    *(LAS f32x4*)xp = (f32x4){y[0], y[1], y[2], y[3]}; *(LAS f32x4*)(xp + 4) = (f32x4){y[4], y[5], y[6], y[7]}; } } \
        } \
        if (ct + 1 < S / 128) {                                         \
_Pragma("unroll") \
            for (int i = 0; i < 7; ++i) { const int tr = ct * 128 + 128 + 4 * tg - 3 + i; rows[i] = *(const u32x4*)(zrx + (size_t)tr * 1024 + 8 * cg); } } \
    } while (0)
    LRU_CONV(0);
    __syncthreads();
    for (int tile = 0; tile < S / 128; ++tile) {
        const int t0 = tile * 128, buf = tile & 1;
        LAS unsigned char* At = lds + LRU_A + buf * 32768; LAS float* XAt = (LAS float*)(lds + LRU_XA + buf * 16384); LAS float* WSt = (LAS float*)(lds + LRU_WS + buf * 2048);
        float Ap[2][4], Hl[2][4], Ai[2], Hi[2];
        {
            f32x4 acc[4];
#pragma unroll
            for (int nt = 0; nt < 4; ++nt) acc[nt] = (f32x4){0.f, 0.f, 0.f, 0.f};
            const int arow = 16 * wave + cc;
#pragma unroll
            for (int ks = 0; ks < 4; ++ks) { const int chunk = 4 * ks + grp;
                const bf16x8 af = *(const LAS bf16x8*)(At + arow * 256 + ((chunk ^ (arow & 15)) << 4));
#pragma unroll
                for (int nt = 0; nt < 4; ++nt) { const int brow = 16 * nt + cc;
                    const bf16x8 bf = *(const LAS bf16x8*)(lds + LRU_BW + brow * 256 + ((chunk ^ (brow & 15)) << 4));
                    acc[nt] = __builtin_amdgcn_mfma_f32_16x16x32_bf16(af, bf, acc[nt], 0, 0, 0); } }
#pragma unroll
            for (int p = 0; p < 2; ++p) { float A = 1.f, H = 0.f;
#pragma unroll
                for (int r = 0; r < 4; ++r) {
                    const float rg = sigmoidf_(acc[p][r] + br_[p]), ig = sigmoidf_(acc[2 + p][r] + bi_[p]);
                    const float la = -rg * sp8[p], a = fast_exp2(la * LOG2E);
                    const float x2 = 2.f * la;
                    const float om = x2 > -0.02f ? -x2 * (1.f + x2 * (0.5f + x2 * (1.f / 6.f))) : 1.f - a * a;
                    const float u = __builtin_amdgcn_sqrtf(om) * ig * XAt[(tk0 + r) * 32 + 2 * cc + p];
                    H = a * H + u; A = A * a; Ap[p][r] = A; Hl[p][r] = H; }
                { const float As = __shfl_up(A, 16), Hs = __shfl_up(H, 16); if (grp >= 1) { H = A * Hs + H; A = A * As; } }
                { const float As = __shfl_up(A, 32), Hs = __shfl_up(H, 32); if (grp >= 2) { H = A * Hs + H; A = A * As; } }
                Ai[p] = A; Hi[p] = H; }
            if (grp == 3) *(LAS f32x4*)(WSt + (wave * 32 + 2 * cc) * 2) = (f32x4){Ai[0], Hi[0], Ai[1], Hi[1]};
        }
        if (tile + 1 < S / 128) LRU_CONV(tile + 1);
        __syncthreads();
        {
            float hw[2] = {hin[0], hin[1]}, hc[2] = {hin[0], hin[1]};
#pragma unroll
            for (int w = 0; w < 8; ++w) { const f32x4 t = *(const LAS f32x4*)(WSt + (w * 32 + 2 * cc) * 2);
                hc[0] = t[0] * hc[0] + t[1]; hc[1] = t[2] * hc[1] + t[3];
                if (w + 1 == wave) { hw[0] = hc[0]; hw[1] = hc[1]; } }
            hin[0] = hc[0]; hin[1] = hc[1];
            float hg[2];
#pragma unroll
            for (int p = 0; p < 2; ++p) { const float Ae = __shfl_up(Ai[p], 16), He = __shfl_up(Hi[p], 16); hg[p] = grp >= 1 ? Ae * hw[p] + He : hw[p]; }
#pragma unroll
            for (int r = 0; r < 4; ++r) { const float h0 = Ap[0][r] * hg[0] + Hl[0][r], h1 = Ap[1][r] * hg[1] + Hl[1][r];
                const unsigned w = cvt_pk_bf16(h0 * bf_lo(gzp[r]), h1 * bf_hi(gzp[r]));
                *(unsigned*)(gz + (size_t)(t0 + tk0 + r) * 1024 + 2 * cc) = w; }
            if (tile + 1 < S / 128) {
#pragma unroll
                for (int r = 0; r < 4; ++r) gzp[r] = *(const unsigned*)(gz + (size_t)(t0 + 128 + tk0 + r) * 1024 + 2 * cc); }
        }
    }
#undef LRU_CONV
    __syncthreads();
}

__device__ __forceinline__ void rope8(const u32x4 a, const u32x4 b, const float* ct, const float* st, u32x4& oa, u32x4& ob) {
    const f32x4 c0 = *(const f32x4*)ct, c1 = *(const f32x4*)(ct + 4), s0 = *(const f32x4*)st, s1 = *(const f32x4*)(st + 4);
    float x1[8], x2[8], cc[8], ss[8];
#pragma unroll
    for (int e = 0; e < 4; ++e) { x1[2 * e] = bf_lo(a[e]); x1[2 * e + 1] = bf_hi(a[e]); x2[2 * e] = bf_lo(b[e]); x2[2 * e + 1] = bf_hi(b[e]); cc[e] = c0[e]; cc[4 + e] = c1[e]; ss[e] = s0[e]; ss[4 + e] = s1[e]; }
#pragma unroll
    for (int e = 0; e < 4; ++e) {
        oa[e] = cvt_pk_bf16(x1[2 * e] * cc[2 * e] - x2[2 * e] * ss[2 * e], x1[2 * e + 1] * cc[2 * e + 1] - x2[2 * e + 1] * ss[2 * e + 1]);
        ob[e] = cvt_pk_bf16(x2[2 * e] * cc[2 * e] + x1[2 * e] * ss[2 * e], x2[2 * e + 1] * cc[2 * e + 1] + x1[2 * e + 1] * ss[2 * e + 1]); }
}
__device__ __forceinline__ void rope_k_pass(const Params& P) {
    unsigned char* ws = P.ws; const float* ct = (const float*)(ws + WS_COS); const float* st = (const float*)(ws + WS_SIN);
    const int gt = blockIdx.x * NTHREADS + opaque_tid(), NGT = gridDim.x * NTHREADS;
    for (int i = gt; i < 2 * 16 * S * 8; i += NGT) { const int ch = i & 7, t = (i >> 3) & (S - 1), bg = (i >> 15) & 15, which = i >> 19;
        bf16_t* row = (bf16_t*)(ws + WS_R_KV) + ((size_t)(((which ? 4 : 2) * 8) * 2 + bg) * S + t) * 128;
        const int tt = (bg >> 1) * S + t;
        const u32x4 a = *(const u32x4*)(row + 8 * ch), b = *(const u32x4*)(row + 64 + 8 * ch); u32x4 oa, ob;
        rope8(a, b, ct + (size_t)tt * 64 + 8 * ch, st + (size_t)tt * 64 + 8 * ch, oa, ob);
        *(u32x4*)(row + 8 * ch) = oa; *(u32x4*)(row + 64 + 8 * ch) = ob; }
}
__device__ __forceinline__ void rope_q_pass(const Params& P) {
    unsigned char* ws = P.ws; const float* ct = (const float*)(ws + WS_COS); const float* st = (const float*)(ws + WS_SIN);
    const int gt = blockIdx.x * NTHREADS + opaque_tid(), NGT = gridDim.x * NTHREADS;
    const bf16_t* q = (const bf16_t*)(ws + WS_R_Q); bf16_t* qr = (bf16_t*)(ws + WS_R_ZRX);
    for (int i = gt; i < T * 8 * 8; i += NGT) { const int ch = i & 7, h = (i >> 3) & 7, t = i >> 6;
        const size_t off = (size_t)t * 1024 + h * 128 + 8 * ch;
        const u32x4 a = *(const u32x4*)(q + off), b = *(const u32x4*)(q + off + 64); u32x4 oa, ob;
        rope8(a, b, ct + (size_t)t * 64 + 8 * ch, st + (size_t)t * 64 + 8 * ch, oa, ob);
        *(u32x4*)(qr + off) = oa; *(u32x4*)(qr + off + 64) = ob; }
}

__device__ __forceinline__ void compress_mlp2(const Params& P, unsigned char* lds_raw) {
    LAS unsigned char* lds = (LAS unsigned char*)lds_raw;
    LAS float* c1s = (LAS float*)(lds + 16 * 528);
    unsigned char* ws = P.ws; const int tid = opaque_tid(), lane = tid & 63, wave = __builtin_amdgcn_readfirstlane(tid >> 6);
    for (int unit = blockIdx.x; unit < 512; unit += gridDim.x) {
        const int j = unit >> 8, bg = (unit >> 4) & 15, n0 = (unit & 15) * 16;
        const bf16_t* G = (const bf16_t*)(ws + WS_G12P) + ((size_t)j * 4096 + bg * 256) * 512;
        if (tid < 256) { float a = P.in[j ? I_B1_V : I_B1_K][tid]; const float* cp = (const float*)(ws + WS_C1P) + (size_t)j * 64 * 256 + tid;
#pragma unroll 16
            for (int c = 0; c < 64; ++c) a += cp[c * 256];
            c1s[tid] = a; }
        __syncthreads();
        { const int r = tid >> 5, h8 = (tid & 31) * 8, n = n0 + r;
          float s[8];
#pragma unroll
          for (int e = 0; e < 8; ++e) s[e] = c1s[h8 + e];
          if (n < NCMP) {
#pragma unroll
              for (int ks = 0; ks < 4; ++ks) { const bf16_t* Gk = G + (size_t)ks * 2 * 4096 * 512;
                  const u32x4 a = *(const u32x4*)(Gk + (size_t)n * 512 + h8), b = *(const u32x4*)(Gk + (size_t)(n + 1) * 512 + 256 + h8);
#pragma unroll
                  for (int e = 0; e < 4; ++e) { s[2 * e] += bf_lo(a[e]) + bf_lo(b[e]); s[2 * e + 1] += bf_hi(a[e]) + bf_hi(b[e]); } }
#pragma unroll
              for (int e = 0; e < 8; ++e) s[e] = gelu_tanh(s[e]);
          } else {
#pragma unroll
              for (int e = 0; e < 8; ++e) s[e] = 0.f; }
          u32x4 w; w.x = cvt_pk_bf16(s[0], s[1]); w.y = cvt_pk_bf16(s[2], s[3]); w.z = cvt_pk_bf16(s[4], s[5]); w.w = cvt_pk_bf16(s[6], s[7]);
          *(LAS u32x4*)(lds + r * 528 + h8 * 2) = w; }
        __syncthreads();
        { const bf16_t* w2t = (const bf16_t*)(ws + WS_W2T) + (size_t)j * 128 * 256 + (size_t)(16 * wave + (lane & 15)) * 256 + 8 * (lane >> 4);
          f32x4 acc = {0.f, 0.f, 0.f, 0.f};
#pragma unroll
          for (int ks = 0; ks < 8; ++ks) { const bf16x8 af = *(const LAS bf16x8*)(lds + (lane & 15) * 528 + (32 * ks + 8 * (lane >> 4)) * 2);
              const bf16x8 bfr = *(const bf16x8*)(w2t + 32 * ks);
              acc = __builtin_amdgcn_mfma_f32_16x16x32_bf16(af, bfr, acc, 0, 0, 0); }
          const int d = 16 * wave + (lane & 15); const float b2 = P.in[j ? I_B2_V : I_B2_K][d];
          bf16_t* kc = (bf16_t*)(ws + WS_KC) + ((size_t)(j * 16 + bg) * 256 + n0) * 128 + d;
#pragma unroll
          for (int r = 0; r < 4; ++r) { const int row = (lane >> 4) * 4 + r; const float v = (n0 + row < NCMP) ? acc[r] + b2 : 0.f; kc[(size_t)row * 128] = (bf16_t)(cvt_pk_bf16(v, 0.f) & 0xffffu); } }
        __syncthreads();
    }
}
namespace att {
constexpr int NW = 8, QBLK = 32, KVBLK = 64, DH = 128;
constexpr int SHM_V = KVBLK * DH * 2, SHM_K = KVBLK * DH * 2;
constexpr int OACC_OFF = 2 * SHM_V + 2 * SHM_K + NW * 64 * 4 + NW * 64 * 4;
constexpr int LDS_BYTES = OACC_OFF + 256 * 256;
constexpr float THR = 8.f;
constexpr float SCALE = ATT_SCALE;
constexpr int WINDOW_W = 512;
#define KSWZ(row, colB) ((row) * 256 + ((colB) ^ (((row) & 7) << 4)))
#define SBAR() __builtin_amdgcn_sched_barrier(0)
__device__ __forceinline__ int v_st(int k, int c) { const int kk = (k & ~0xC) | ((k & 4) << 1) | ((k & 8) >> 1); return ((kk >> 3) * 4 + (c >> 5)) * 512 + ((kk & 7) * 32 + (c & 31)) * 2; }
__device__ __forceinline__ int v_rd_base(int lane) { return ((lane & 3) << 3) | (((lane >> 2) & 3) << 6) | (((lane >> 4) & 1) << 5) | (((lane >> 5) & 1) << 8); }
constexpr int v_rd_off(int d0, int ks, int half) { return d0 * 512 + ks * 4096 + half * 2048; }
__device__ __forceinline__ int crow(int r, int hi) { return (r & 3) + 8 * (r >> 2) + 4 * hi; }
__device__ __forceinline__ unsigned cvtpk(float lo, float hi) { unsigned r; asm volatile("v_cvt_pk_bf16_f32 %0, %1, %2" : "=v"(r) : "v"(lo), "v"(hi)); return r; }
__device__ __forceinline__ bf16x8 load8(const bf16_t* p) { return *reinterpret_cast<const bf16x8*>(p); }
__device__ __forceinline__ void mask_tile(f32x16& p0, f32x16& p1, int dq, unsigned W) {
    const float NEG = -__builtin_inff();
#pragma unroll
    for (int r = 0; r < 16; ++r) {
        const int c = (r & 3) + 8 * (r >> 2);
        if ((unsigned)(dq - c) >= W) p0[r] = NEG;
        if ((unsigned)(dq - c - 32) >= W) p1[r] = NEG;
    }
}
__device__ __forceinline__ void mask_all(f32x16& p0, f32x16& p1, bool kill) {
    const float NEG = -__builtin_inff();
#pragma unroll
    for (int r = 0; r < 16; ++r) { p0[r] = kill ? NEG : p0[r]; p1[r] = kill ? NEG : p1[r]; }
}
__device__ __forceinline__ void partialSM(f32x16& p0, f32x16& p1, float& m_reg, float& mn, float& alpha, bool on = true) {
    float pmax = p0[0]; for (int r = 1; r < 16; ++r) pmax = fmaxf(pmax, p0[r]); for (int r = 0; r < 16; ++r) pmax = fmaxf(pmax, p1[r]);
    pmax = on ? pmax : -__builtin_inff();
    { auto rr = __builtin_amdgcn_permlane32_swap(__float_as_uint(pmax), __float_as_uint(pmax), false, false);
      pmax = fmaxf(__uint_as_float(rr[0]), __uint_as_float(rr[1])); }
    constexpr float C2 = 1.4426950408889634f * SCALE;
    if (__builtin_expect(__all((pmax - m_reg) * SCALE <= THR), 1)) { mn = m_reg; alpha = 1.f; }
    else { mn = fmaxf(m_reg, pmax); alpha = __builtin_amdgcn_exp2f((m_reg - mn) * C2); m_reg = mn; }
    const float mnL = on ? -mn * C2 : -__builtin_inff();
    for (int r = 0; r < 16; ++r) p0[r] = fmaf(p0[r], C2, mnL); for (int r = 0; r < 16; ++r) p1[r] = fmaf(p1[r], C2, mnL);
    for (int r = 0; r < 16; ++r) p0[r] = __builtin_amdgcn_exp2f(p0[r]);
}
__device__ __forceinline__ void finishSM(f32x16& p0, f32x16& p1, float alpha, float& l_reg, bf16x8& pa0, bf16x8& pa1, bf16x8& pa2, bf16x8& pa3) {
    for (int r = 0; r < 16; ++r) p1[r] = __builtin_amdgcn_exp2f(p1[r]);
    float ps = 0; for (int r = 0; r < 16; ++r) ps += p0[r]; for (int r = 0; r < 16; ++r) ps += p1[r];
    { auto rr = __builtin_amdgcn_permlane32_swap(__float_as_uint(ps), __float_as_uint(ps), false, false);
      ps = __uint_as_float(rr[0]) + __uint_as_float(rr[1]); }
    l_reg = l_reg * alpha + ps;
#define PK4(Pv, B_, OUT) do { unsigned a0 = cvtpk(Pv[B_+0], Pv[B_+1]), a1 = cvtpk(Pv[B_+2], Pv[B_+3]);                          \
        unsigned b0 = cvtpk(Pv[B_+4], Pv[B_+5]), b1 = cvtpk(Pv[B_+6], Pv[B_+7]);                                             \
        auto r0 = __builtin_amdgcn_permlane32_swap(a0, b0, false, false); auto r1 = __builtin_amdgcn_permlane32_swap(a1, b1, false, false); \
        u32x4 w = {r0[0], r1[0], r0[1], r1[1]}; OUT = *reinterpret_cast<bf16x8*>(&w); } while (0)
    PK4(p0, 0, pa0); PK4(p0, 8, pa1); PK4(p1, 0, pa2); PK4(p1, 8, pa3);
#undef PK4
}
__device__ __forceinline__ void qkt(f32x16& p0, f32x16& p1, const char* kbase, int r32, int hi, const bf16x8* qr) {
    p0 = f32x16{}; p1 = f32x16{};
    const char* kb[4];
#pragma unroll
    for (int dd = 0; dd < 4; ++dd) kb[dd] = kbase + KSWZ(r32, (dd * 16 + hi * 8) * 2);
#pragma unroll
    for (int d0 = 0; d0 < 8; ++d0) { const char* a = kb[d0 & 3] + (d0 >> 2) * 128;
        bf16x8 b0 = *reinterpret_cast<const bf16x8*>(a);
        bf16x8 b1 = *reinterpret_cast<const bf16x8*>(a + 32 * 256);
        p0 = __builtin_amdgcn_mfma_f32_32x32x16_bf16(b0, qr[d0], p0, 0, 0, 0);
        p1 = __builtin_amdgcn_mfma_f32_32x32x16_bf16(b1, qr[d0], p1, 0, 0, 0); }
}
template <int VB>
__device__ __forceinline__ void pv_tile(f32x16* o, int vb0, bf16x8 pa0, bf16x8 pa1, bf16x8 pa2, bf16x8 pa3) {
#define TRRD(dst, off) asm volatile("ds_read_b64_tr_b16 %0, %1 offset:%2" : "=&v"(dst) : "v"(vb0), "i"(off) : "memory")
#define PV_D0(d0) do { s16x4 l0, l1, l2, l3, h0, h1, h2, h3; constexpr int b_ = VB * SHM_V + v_rd_off(d0, 0, 0); \
        TRRD(l0, b_); TRRD(h0, b_ + 2048); TRRD(l1, b_ + 4096); TRRD(h1, b_ + 6144); TRRD(l2, b_ + 8192); TRRD(h2, b_ + 10240); TRRD(l3, b_ + 12288); TRRD(h3, b_ + 14336); \
        asm volatile("s_waitcnt lgkmcnt(0)" ::: "memory"); SBAR();   \
        o[d0] = __builtin_amdgcn_mfma_f32_32x32x16_bf16(pa0, (bf16x8){l0[0], l0[1], l0[2], l0[3], h0[0], h0[1], h0[2], h0[3]}, o[d0], 0, 0, 0);   \
        o[d0] = __builtin_amdgcn_mfma_f32_32x32x16_bf16(pa1, (bf16x8){l1[0], l1[1], l1[2], l1[3], h1[0], h1[1], h1[2], h1[3]}, o[d0], 0, 0, 0);   \
        o[d0] = __builtin_amdgcn_mfma_f32_32x32x16_bf16(pa2, (bf16x8){l2[0], l2[1], l2[2], l2[3], h2[0], h2[1], h2[2], h2[3]}, o[d0], 0, 0, 0);   \
        o[d0] = __builtin_amdgcn_mfma_f32_32x32x16_bf16(pa3, (bf16x8){l3[0], l3[1], l3[2], l3[3], h3[0], h3[1], h3[2], h3[3]}, o[d0], 0, 0, 0); } while (0)
    PV_D0(0); PV_D0(1); PV_D0(2); PV_D0(3);
#undef PV_D0
#undef TRRD
}

enum { MODE_CMP = 0, MODE_SEL = 1, MODE_WIN = 2 };
struct Blk {
    const bf16_t* Q;
    const bf16_t* K; const bf16_t* V;
    bf16_t* O;
    const float* gate;
    const unsigned* sel;
    int t0, mode, jlo, NT;
};
struct Seam { bf16x8 qr[8]; bf16x8 st_v0, st_v1, st_k0, st_k1; };

#define ROW(p, k0, rr) ((p) + (size_t)((k0) + (rr)) * DH + sc)
#define VMW() asm volatile("s_waitcnt vmcnt(0)" ::: "memory")
#define VMWN(n) asm volatile("s_waitcnt vmcnt(%0)" :: "i"(n) : "memory")
#define SLOAD_H(Kp, Vp, k0) do { S.st_v0 = load8(ROW(Vp, k0, sr)); S.st_v1 = load8(ROW(Vp, k0, 32 + sr)); S.st_k0 = load8(ROW(Kp, k0, sr)); S.st_k1 = load8(ROW(Kp, k0, 32 + sr)); } while (0)
#define SWRITE_HK(bf) do { *(bf16x8*)(K_lds + (bf) * SHM_K + kws) = S.st_k0; *(bf16x8*)(K_lds + (bf) * SHM_K + kws + 32 * 256) = S.st_k1; } while (0)
#define SWRITE_HV(bf) do { *(bf16x8*)(V_lds + (bf) * SHM_V + vst0) = S.st_v0; *(bf16x8*)(V_lds + (bf) * SHM_V + vst1) = S.st_v1; } while (0)
#define SWRITE_H(bf) do { SWRITE_HV(bf); SWRITE_HK(bf); } while (0)
#define QPTR(ref) ((ref).Q + (size_t)((wid & 1) * 32 + r32) * 1024 + (wid >> 1) * 128 + hi * 8)

__device__ __forceinline__ void attn_prime(const Blk& cur, char* lds, Seam& S) {
    const int tid = opaque_tid(), wid = __builtin_amdgcn_readfirstlane(tid >> 6), lane = tid & 63, r32 = lane & 31, hi = lane >> 5;
    const int sr = tid >> 4, sc = (tid & 15) * 8, kws = KSWZ(sr, sc * 2); char* K_lds = lds + 2 * SHM_V;
    const int kb0 = cur.jlo * KVBLK;
    const bf16_t* qp = QPTR(cur);
#pragma unroll
    for (int d0 = 0; d0 < 8; ++d0) S.qr[d0] = load8(qp + d0 * 16);
    SLOAD_H(cur.K, cur.V, kb0); VMW(); SWRITE_HK(0);
    __syncthreads();
}
__device__ __forceinline__ void attn_block(const Blk& cur, const Blk& nxt, char* lds, Seam& S) {
    const int tid = opaque_tid();
    const int wid = __builtin_amdgcn_readfirstlane(tid >> 6), lane = tid & 63, r32 = lane & 31, hi = lane >> 5;
    const int j_lo = cur.jlo, NT = cur.NT, mode = cur.mode;
    const int kbn = nxt.jlo * KVBLK;
    const int qlo = cur.t0 + (wid & 1) * QBLK, tok = qlo + r32;
    const int lim = (mode == MODE_CMP) ? ((tok - 31) >> 4) : tok;
    const int qm = lim - 4 * hi;
    char* V_lds = lds; char* K_lds = lds + 2 * SHM_V;
    float* wsm = (float*)(lds + 2 * SHM_V + 2 * SHM_K) + wid * 64; float* li_l = wsm, * al_l = wsm + 32;
    unsigned* sel_l = (unsigned*)(lds + 2 * SHM_V + 2 * SHM_K + NW * 64 * 4) + wid * 64;
    if (mode == MODE_SEL) { const unsigned* sp = cur.sel + (size_t)((wid & 1) * 32 + r32) * 4; sel_l[r32 * 2 + hi] = sp[hi]; }
    float m_reg = -1e30f, l_reg = 0; f32x16 o[4] = {};
    const int sr = tid >> 4, sc = (tid & 15) * 8, vst0 = v_st(sr, sc), vst1 = v_st(32 + sr, sc), kws = KSWZ(sr, sc * 2);
    const int vb0 = (int)(uintptr_t)V_lds + v_rd_base(lane);
    const bf16_t* Kh = cur.K; const bf16_t* Vh = cur.V;
#define RESC(a) do { if (__any((a) < 1.f)) { if (hi == 0) al_l[r32] = (a); asm volatile("s_waitcnt lgkmcnt(0)" ::: "memory");              \
                     for (int d_ = 0; d_ < 4; ++d_) for (int r = 0; r < 16; ++r) o[d_][r] *= al_l[crow(r, hi)]; } } while (0)
#define KBASE(t) ((j_lo + (t)) * KVBLK)
#define MASKT(P0_, P1_, t) do { const int kb_ = KBASE(t);                                                                                          \
        if (mode == MODE_CMP) { mask_tile(P0_, P1_, qm - kb_, 0x7fffffffu); }                                                                       \
        else if (mode == MODE_WIN) { if (kb_ + KVBLK - 1 > qlo || kb_ <= qlo + QBLK - 1 - WINDOW_W) mask_tile(P0_, P1_, qm - kb_, (unsigned)WINDOW_W); } \
        else { const int jb_ = j_lo + (t); const unsigned sw_ = sel_l[r32 * 2 + (jb_ >> 5)]; lane_on = (sw_ >> (jb_ & 31)) & 1u;                        \
               if (kb_ + KVBLK - 1 > qlo) mask_tile(P0_, P1_, qm - kb_, 0x7fffffffu); } } while (0)
    constexpr int NQL = 8;
#define SEAM_K0() do { VMWN(NQL); SWRITE_HK(0); SBAR(); } while (0)
    f32x16 pA0, pA1, pB0, pB1; float mnA, mnB, alA, alB; bf16x8 pa0, pa1, pa2, pa3; bool lane_on = true;
    SWRITE_HV(0); SBAR();
    if (NT > 1) SLOAD_H(Kh, Vh, KBASE(1));
    SBAR(); qkt(pA0, pA1, K_lds, r32, hi, S.qr);
    MASKT(pA0, pA1, 0); partialSM(pA0, pA1, m_reg, mnA, alA, lane_on);
    if (NT > 1) { VMW(); SWRITE_H(1); }
    __syncthreads();
#define HALF_STEP(PX0, PX1, mnX, alX, PY0, PY1, alY, t, KB, VB, SB) do {                                                      \
        SBAR(); qkt(PX0, PX1, K_lds + (KB) * SHM_K, r32, hi, S.qr);                                                            \
        finishSM(PY0, PY1, alY, l_reg, pa0, pa1, pa2, pa3); SBAR();                                                           \
        if ((t) + 1 < NT) { SLOAD_H(Kh, Vh, KBASE((t) + 1)); SBAR(); }                                                        \
        pv_tile<VB>(o, vb0, pa0, pa1, pa2, pa3); MASKT(PX0, PX1, (t)); partialSM(PX0, PX1, m_reg, mnX, alX, lane_on);                  \
        __syncthreads();                                                                                                      \
        if ((t) + 1 < NT) { VMW(); SWRITE_H(SB); }                                                                            \
        RESC(alX); __syncthreads(); } while (0)
    for (int t = 1; t + 1 < NT; t += 2) {
        HALF_STEP(pB0, pB1, mnB, alB, pA0, pA1, alA, t, 1, 0, 0);
        HALF_STEP(pA0, pA1, mnA, alA, pB0, pB1, alB, t + 1, 0, 1, 1);
    }
    const bool even = (NT & 1) == 0;
    if (even) { SBAR(); qkt(pB0, pB1, K_lds + SHM_K, r32, hi, S.qr); SBAR(); }
    SLOAD_H(nxt.K, nxt.V, kbn); SBAR();
    { const bf16_t* qp = QPTR(nxt);
#pragma unroll
      for (int d0 = 0; d0 < 8; ++d0) S.qr[d0] = load8(qp + d0 * 16); }
    SBAR();
    finishSM(pA0, pA1, alA, l_reg, pa0, pa1, pa2, pa3); SBAR();
    pv_tile<0>(o, vb0, pa0, pa1, pa2, pa3);
    if (even) { MASKT(pB0, pB1, NT - 1); partialSM(pB0, pB1, m_reg, mnB, alB, lane_on); __syncthreads(); RESC(alB);
        finishSM(pB0, pB1, alB, l_reg, pa0, pa1, pa2, pa3); SBAR(); pv_tile<1>(o, vb0, pa0, pa1, pa2, pa3); }
    SBAR(); SEAM_K0();
    if (hi == 0) { li_l[r32] = l_reg; al_l[r32] = cur.gate[(size_t)((wid & 1) * 32 + r32) * 24 + (wid >> 1) * 3]; }
    asm volatile("s_waitcnt lgkmcnt(0)" ::: "memory");
    float rli[16];
#pragma unroll
    for (int r = 0; r < 16; ++r) { const float lv = li_l[crow(r, hi)]; rli[r] = lv > 0.f ? al_l[crow(r, hi)] * __builtin_amdgcn_rcpf(lv) : 0.f; }
    char* oacc = lds + OACC_OFF + wid * 32 * 256;
#pragma unroll
    for (int r = 0; r < 16; ++r) { const int orow = crow(r, hi);
#pragma unroll
        for (int d0 = 0; d0 < 4; ++d0) { float v = o[d0][r] * rli[r]; float vn = __shfl_xor(v, 1);
            if ((r32 & 1) == 0) { unsigned* dst = (unsigned*)(oacc + orow * 256 + (d0 * 32 + r32) * 2);
                if (mode != MODE_CMP) { const unsigned old = *dst; v += bf_lo(old); vn += bf_hi(old); }
                *dst = cvtpk(v, vn); } } }
    __syncthreads();
    if (mode == MODE_WIN) {
#pragma unroll
        for (int i = 0; i < 8; ++i) { const int idx = tid + 512 * i, rho = idx >> 4, c16 = idx & 15, wv = rho >> 5;
            const u32x4 val = *(const u32x4*)(lds + OACC_OFF + rho * 256 + c16 * 16);
            *(u32x4*)(cur.O + (size_t)((wv & 1) * 32 + (rho & 31)) * 1024 + (wv >> 1) * 128 + c16 * 8) = val; }
    }
#undef RESC
#undef KBASE
#undef MASKT
#undef SEAM_K0
#undef HALF_STEP
}

__device__ __forceinline__ void imp_unit(const Params& P, char* lds, int bg, int tq) {
    const int tid = opaque_tid();
    const int wid = __builtin_amdgcn_readfirstlane(tid >> 6), lane = tid & 63, r32 = lane & 31, hi = lane >> 5;
    unsigned char* ws = P.ws; const int b = bg >> 1, g = bg & 1;
    const bf16_t* kc = (const bf16_t*)(ws + WS_KC) + (size_t)bg * 256 * 128;
    { const int sr = tid >> 4, sc = (tid & 15) * 8;
#pragma unroll
      for (int p = 0; p < 8; ++p) { const int row = sr + 32 * p; *(bf16x8*)(lds + (row >> 6) * SHM_K + KSWZ(row & 63, sc * 2)) = load8(kc + (size_t)row * 128 + sc); } }
    __syncthreads();
    const int tok = tq * 256 + wid * 32 + r32, lim4 = ((tok - 31) >> 4) - 4 * hi;
    const bf16_t* qrow = (const bf16_t*)(ws + WS_R_Q) + (size_t)(b * S + tok) * 1024 + g * 512 + hi * 8;
    constexpr float C2 = 1.4426950408889634f * SCALE;
    float accG[32], accL[32];
#pragma unroll
    for (int i = 0; i < 32; ++i) { accG[i] = 0.f; accL[i] = 0.f; }
    for (int h = 0; h < 4; ++h) {
        bf16x8 qr[8];
#pragma unroll
        for (int d0 = 0; d0 < 8; ++d0) qr[d0] = load8(qrow + h * 128 + d0 * 16);
        float m = -1e30f, l = 0.f;
        int lim4a = lim4; asm volatile("" : "+v"(lim4a));
#pragma unroll
        for (int t = 0; t < 4; ++t) { f32x16 p0, p1; qkt(p0, p1, lds + t * SHM_K, r32, hi, qr); mask_tile(p0, p1, lim4a - 64 * t, 0x7fffffffu);
            float pmax = p0[0];
#pragma unroll
            for (int r = 1; r < 16; ++r) pmax = fmaxf(pmax, p0[r]);
#pragma unroll
            for (int r = 0; r < 16; ++r) pmax = fmaxf(pmax, p1[r]);
            { auto rr = __builtin_amdgcn_permlane32_swap(__float_as_uint(pmax), __float_as_uint(pmax), false, false); pmax = fmaxf(__uint_as_float(rr[0]), __uint_as_float(rr[1])); }
            const float mn = fmaxf(m, pmax); float ps = 0.f;
#pragma unroll
            for (int r = 0; r < 16; ++r) ps += __builtin_amdgcn_exp2f((p0[r] - mn) * C2) + __builtin_amdgcn_exp2f((p1[r] - mn) * C2);
            l = l * __builtin_amdgcn_exp2f((m - mn) * C2) + ps; m = mn; SBAR(); }
        { auto rr = __builtin_amdgcn_permlane32_swap(__float_as_uint(l), __float_as_uint(l), false, false); l = __uint_as_float(rr[0]) + __uint_as_float(rr[1]); }
        const float inv = l > 0.f ? 1.0f / l : 0.f;
        int lim4b = lim4; asm volatile("" : "+v"(lim4b));
#pragma unroll
        for (int t = 0; t < 4; ++t) { f32x16 p0, p1; qkt(p0, p1, lds + t * SHM_K, r32, hi, qr); mask_tile(p0, p1, lim4b - 64 * t, 0x7fffffffu);
#pragma unroll
            for (int q = 0; q < 4; ++q) {
                const float e0 = __builtin_amdgcn_exp2f((p0[4 * q] - m) * C2), e1 = __builtin_amdgcn_exp2f((p0[4 * q + 1] - m) * C2), e2 = __builtin_amdgcn_exp2f((p0[4 * q + 2] - m) * C2), e3 = __builtin_amdgcn_exp2f((p0[4 * q + 3] - m) * C2);
                accG[t * 8 + q] += ((e0 + e1) + (e2 + e3)) * inv; accL[t * 8 + q] += e3 * inv;
                const float f0 = __builtin_amdgcn_exp2f((p1[4 * q] - m) * C2), f1 = __builtin_amdgcn_exp2f((p1[4 * q + 1] - m) * C2), f2 = __builtin_amdgcn_exp2f((p1[4 * q + 2] - m) * C2), f3 = __builtin_amdgcn_exp2f((p1[4 * q + 3] - m) * C2);
                accG[t * 8 + 4 + q] += ((f0 + f1) + (f2 + f3)) * inv; accL[t * 8 + 4 + q] += f3 * inv; } SBAR(); }
    }
    unsigned r16[16];
#pragma unroll
    for (int s = 0; s < 16; ++s) r16[s] = 0u;
#define TOPK_INS(X) do { unsigned x_ = (X); _Pragma("unroll") for (int s = 0; s < 16; ++s) { const unsigned hi_ = r16[s] > x_ ? r16[s] : x_; x_ = r16[s] > x_ ? x_ : r16[s]; r16[s] = hi_; } } while (0)
    int cur = tok >> 6; asm volatile("" : "+v"(cur));
    float plprev = 0.f;
#pragma unroll
    for (int i = 0; i < 32; ++i) {
        auto rr = __builtin_amdgcn_permlane32_swap(__float_as_uint(accL[i]), __float_as_uint(accL[i]), false, false);
        const float pl = __uint_as_float(hi ? rr[0] : rr[1]);
        const float imp = accG[i] + (hi ? pl : plprev); plprev = pl;
        const int j = 2 * i + hi; const bool forced = (j == 0) | (j == cur) | (j == cur - 1), valid = j <= cur;
        const unsigned key = forced ? (0x7f800000u | (unsigned)(63 - j)) : valid ? ((__float_as_uint(imp) & ~63u) | (unsigned)(63 - j)) : 0u;
        TOPK_INS(key);
        if ((i & 3) == 3) SBAR();
    }
    unsigned mine[16];
#pragma unroll
    for (int s = 0; s < 16; ++s) mine[s] = r16[s];
#pragma unroll
    for (int s = 0; s < 16; ++s) { auto rr = __builtin_amdgcn_permlane32_swap(mine[s], mine[s], false, false); TOPK_INS(hi ? rr[0] : rr[1]); }
#undef TOPK_INS
    unsigned m0 = 0u, m1 = 0u;
#pragma unroll
    for (int s = 0; s < 16; ++s) if (r16[s]) { const unsigned j = 63u - (r16[s] & 63u); if (j < 32u) m0 |= 1u << j; else m1 |= 1u << (j - 32u); }
    if (hi == 0) { unsigned* sp = (unsigned*)(ws + WS_SEL) + ((size_t)(b * S + tok) * 2 + g) * 2; sp[0] = m0; sp[1] = m1; }
    __syncthreads();
}
#undef ROW
#undef VMW
#undef VMWN
#undef SLOAD_H
#undef SWRITE_HK
#undef SWRITE_HV
#undef SWRITE_H
#undef QPTR
}
#define XB_TMO      128
#define XB_XCNT(j)  (256  + 64 * (j))
#define XB_XSUB(j)  (1280 + 64 * (j))
#define XB_XGEN(j)  (2304 + 64 * (j))
#define XB_TOP      3328
#define XB_TOPGEN   3392
#define XCD_BAR_WORDS 3456
#define XB_SPIN_CAP (1u << 18)

__device__ __forceinline__ unsigned xb_ld(unsigned* p)              { return __hip_atomic_load(p, __ATOMIC_RELAXED, __HIP_MEMORY_SCOPE_AGENT); }
__device__ __forceinline__ unsigned xb_add(unsigned* p, unsigned v) { return __hip_atomic_fetch_add(p, v, __ATOMIC_RELAXED, __HIP_MEMORY_SCOPE_AGENT); }
__device__ __forceinline__ unsigned xb_xcc_id() { return (unsigned)__builtin_amdgcn_s_getreg((3 << 11) | 20) & 0xFu; }
#define XB_SPIN(cond, bar) do { unsigned _sp = 0; while (cond) { __builtin_amdgcn_s_sleep(1); \
    if ((++_sp & 255u) == 0u) { if (xb_ld(&(bar)[XB_TMO])) break; if (_sp > XB_SPIN_CAP) { atomicAdd(&(bar)[XB_TMO], 1u); break; } } } } while (0)

struct XcdBarrier {
    unsigned* bar; unsigned x;
    volatile LAS unsigned* st;
};

__device__ __forceinline__ XcdBarrier xcd_barrier_post(unsigned* bar, volatile LAS unsigned* st) {
    XcdBarrier b; b.bar = bar; b.x = xb_xcc_id(); b.st = st;
    if (opaque_tid() == 0) (void)xb_add(&bar[XB_XCNT(b.x)], 1u);
    return b;
}
__device__ __forceinline__ void xcd_barrier_complete(unsigned* bar, unsigned x, unsigned& nloc, unsigned& nx) {
    const unsigned G = gridDim.x * gridDim.y * gridDim.z;
    unsigned sum, cnt, mine, sp = 0u;
    for (;;) {
        sum = 0u; cnt = 0u; mine = 0u;
#pragma unroll
        for (unsigned j = 0; j < 16; ++j) { const unsigned c = xb_ld(&bar[XB_XCNT(j)]); sum += c; cnt += (c > 0u) ? 1u : 0u; mine = (j == x) ? c : mine; }
        if (sum == G) break;
        __builtin_amdgcn_s_sleep(1);
        if ((++sp & 255u) == 0u) { if (xb_ld(&bar[XB_TMO])) break; if (sp > XB_SPIN_CAP) { atomicAdd(&bar[XB_TMO], 1u); break; } }
    }
    nloc = mine > 0u ? mine : 1u; nx = cnt > 0u ? cnt : 1u;
}

__device__ __forceinline__ void xcd_barrier(const XcdBarrier& b) {
    asm volatile("s_waitcnt vmcnt(0)" ::: "memory");
    __syncthreads();
    if (opaque_tid() == 0) {
        unsigned* bar = b.bar;
        __builtin_amdgcn_s_waitcnt(0);
        unsigned nloc = b.st[0], nx = b.st[1];
        if (nloc == 0u) { xcd_barrier_complete(bar, b.x, nloc, nx); b.st[0] = nloc; b.st[1] = nx; }
        const unsigned old = xb_add(&bar[XB_XSUB(b.x)], 1u);
        const unsigned gen = old / nloc;
        if (old + 1u == (gen + 1u) * nloc) {
            __builtin_amdgcn_fence(__ATOMIC_RELEASE, "agent");
            asm volatile("s_waitcnt vmcnt(0)" ::: "memory");
            const unsigned og = xb_add(&bar[XB_TOP], 1u);
            const unsigned tg = og / nx;
            if (og + 1u == (tg + 1u) * nx) xb_add(&bar[XB_TOPGEN], 1u);
            else XB_SPIN(xb_ld(&bar[XB_TOPGEN]) == tg, bar);
            __builtin_amdgcn_fence(__ATOMIC_ACQUIRE, "agent");
            xb_add(&bar[XB_XGEN(b.x)], 1u);
            asm volatile("s_waitcnt vmcnt(0)" ::: "memory");
        } else {
            XB_SPIN(xb_ld(&bar[XB_XGEN(b.x)]) == gen, bar);
            __builtin_amdgcn_fence(__ATOMIC_ACQUIRE, "agent");
            asm volatile("s_waitcnt vmcnt(0)" ::: "memory");
        }
    }
    __syncthreads();
}
namespace peer {
__device__ __forceinline__ unsigned sortable(float f) { const unsigned u = __float_as_uint(f); return u ^ ((unsigned)((int)u >> 31) | 0x80000000u); }
__device__ __forceinline__ float unsortable(unsigned k) { const unsigned u = (k & 0x80000000u) ? (k ^ 0x80000000u) : ~k; return __uint_as_float(u); }
__device__ __forceinline__ void sort16_desc(unsigned (&v)[16]) {
#pragma unroll
    for (int k = 2; k <= 16; k <<= 1)
#pragma unroll
        for (int j = k >> 1; j > 0; j >>= 1)
#pragma unroll
            for (int i = 0; i < 16; ++i) { const int l = i ^ j; if (l > i) { const bool desc = (i & k) == 0; const unsigned a = v[i], b = v[l], mx = a > b ? a : b, mn = a > b ? b : a; v[i] = desc ? mx : mn; v[l] = desc ? mn : mx; } }
}
__device__ __forceinline__ void merge16_desc(unsigned (&a)[16], const unsigned (&b)[16]) {
#pragma unroll
    for (int i = 0; i < 16; ++i) a[i] = a[i] > b[15 - i] ? a[i] : b[15 - i];
#pragma unroll
    for (int j = 8; j > 0; j >>= 1)
#pragma unroll
        for (int i = 0; i < 16; ++i) { const int l = i ^ j; if (l > i) { const unsigned x = a[i], y = a[l]; a[i] = x > y ? x : y; a[l] = x > y ? y : x; } }
}
#define INS16(R, X) do { unsigned x_ = (X); _Pragma("unroll") for (int s_ = 0; s_ < 16; ++s_) { const unsigned h_ = R[s_] > x_ ? R[s_] : x_; x_ = R[s_] > x_ ? x_ : R[s_]; R[s_] = h_; } } while (0)

__device__ __forceinline__ void stage_keys(const Params& P, LAS unsigned char* lds) {
    const int tid = opaque_tid();
    { const float* keys = P.in[I_PEER_KEYS];
      for (int i = tid; i < 2 * 128 * 8; i += NTHREADS) { const int ch = i & 7, row = i >> 3;
          const f32x4 a = *(const f32x4*)(keys + (size_t)row * 64 + ch * 8), b = *(const f32x4*)(keys + (size_t)row * 64 + ch * 8 + 4);
          *(LAS u32x4*)(lds + row * 128 + ((ch ^ (row & 7)) << 4)) = pack8(a, b); } }
    __syncthreads();
}
__device__ __forceinline__ void topk_item(const bf16_t* qp, LAS unsigned char* lds, int item, LAS int* e_out, LAS float* g_out) {
        const int lane2 = opaque_tid() & 63, r32 = lane2 & 31, hi = lane2 >> 5;
        const int tok = item * 4 + (r32 >> 3), head = r32 & 7;
        const bf16_t* qrow = qp + (size_t)tok * 1024 + head * 128 + hi * 8;
        unsigned L[2][16];
        int kb4[4];
#pragma unroll
        for (int ks = 0; ks < 4; ++ks) kb4[ks] = r32 * 128 + (((ks * 2 + hi) ^ (r32 & 7)) << 4);
#pragma unroll
        for (int c = 0; c < 2; ++c) {
            bf16x8 qf[4];
#pragma unroll
            for (int ks = 0; ks < 4; ++ks) qf[ks] = *(const bf16x8*)(qrow + c * 64 + ks * 16);
            unsigned r16[16];
#pragma unroll
            for (int kt = 0; kt < 4; ++kt) {
                f32x16 p = {};
#pragma unroll
                for (int ks = 0; ks < 4; ++ks) { const bf16x8 kf = *(const LAS bf16x8*)(lds + kb4[ks] + (c * 128 + kt * 32) * 128);
                    p = __builtin_amdgcn_mfma_f32_32x32x16_bf16(kf, qf[ks], p, 0, 0, 0); }
                unsigned g16[16];
#pragma unroll
                for (int r = 0; r < 16; ++r) { const int n = kt * 32 + (r & 3) + 8 * (r >> 2) + 4 * hi; g16[r] = (sortable(p[r]) & ~127u) | (unsigned)(127 - n); }
                sort16_desc(g16);
                if (kt == 0) {
#pragma unroll
                    for (int s = 0; s < 16; ++s) r16[s] = g16[s]; }
                else merge16_desc(r16, g16);
                __builtin_amdgcn_sched_barrier(0);
            }
            { unsigned pr[16];
#pragma unroll
              for (int s = 0; s < 16; ++s) { auto rr = __builtin_amdgcn_permlane32_swap(r16[s], r16[s], false, false); pr[s] = hi ? rr[0] : rr[1]; }
              merge16_desc(r16, pr); }
#pragma unroll
            for (int s = 0; s < 16; ++s) L[c][s] = r16[s];
        }
        unsigned key[16], pay[16];
#pragma unroll
        for (int s = 0; s < 16; ++s) { key[s] = 0u; pay[s] = 0u; }
#pragma unroll
        for (int i = 0; i < 16; ++i) {
            const float v1 = unsortable(L[0][i] & ~127u); const unsigned i1 = 127u - (L[0][i] & 127u);
#pragma unroll
            for (int j = 0; j < 16; ++j) {
                if ((i + 1) * (j + 1) <= 16) {
                    const float v2 = unsortable(L[1][j] & ~127u); const unsigned i2 = 127u - (L[1][j] & 127u);
                    unsigned xk = (sortable(v1 + v2) & ~255u) | (unsigned)(255 - (i * 16 + j)), xp = i1 * 128u + i2;
#pragma unroll
                    for (int s = (i + 1) * (j + 1) - 1; s < 16; ++s) { const bool gt = xk > key[s];
                        const unsigned nk = gt ? xk : key[s], np = gt ? xp : pay[s]; xk = gt ? key[s] : xk; xp = gt ? pay[s] : xp; key[s] = nk; pay[s] = np; }
                }
            }
            __builtin_amdgcn_sched_barrier(0);
        }
        float bv[16], den = 0.f; const float bm = unsortable(key[0] & ~255u);
#pragma unroll
        for (int s = 0; s < 16; ++s) { bv[s] = __builtin_amdgcn_exp2f((unsortable(key[s] & ~255u) - bm) * LOG2E); den += bv[s]; }
        const float rden = 1.0f / den;
        if (hi == 0) { LAS int* ep = e_out + (r32 >> 3) * 128 + head * 16; LAS float* gp = g_out + (r32 >> 3) * 128 + head * 16;
#pragma unroll
            for (int s4 = 0; s4 < 4; ++s4) { *(LAS u32x4*)(ep + 4 * s4) = (u32x4){pay[4 * s4], pay[4 * s4 + 1], pay[4 * s4 + 2], pay[4 * s4 + 3]};
                *(LAS f32x4*)(gp + 4 * s4) = (f32x4){bv[4 * s4] * rden, bv[4 * s4 + 1] * rden, bv[4 * s4 + 2] * rden, bv[4 * s4 + 3] * rden}; } }
}
__device__ __forceinline__ float dpp_sum16(float v) {
    v += __uint_as_float(__builtin_amdgcn_mov_dpp(__float_as_uint(v), 0xB1, 0xf, 0xf, true));
    v += __uint_as_float(__builtin_amdgcn_mov_dpp(__float_as_uint(v), 0x4E, 0xf, 0xf, true));
    v += __uint_as_float(__builtin_amdgcn_mov_dpp(__float_as_uint(v), 0x141, 0xf, 0xf, true));
    v += __uint_as_float(__builtin_amdgcn_mov_dpp(__float_as_uint(v), 0x140, 0xf, 0xf, true));
    return v;
}
__device__ __forceinline__ float dpp_max16(float v) {
    v = fmaxf(v, __uint_as_float(__builtin_amdgcn_mov_dpp(__float_as_uint(v), 0xB1, 0xf, 0xf, true)));
    v = fmaxf(v, __uint_as_float(__builtin_amdgcn_mov_dpp(__float_as_uint(v), 0x4E, 0xf, 0xf, true)));
    v = fmaxf(v, __uint_as_float(__builtin_amdgcn_mov_dpp(__float_as_uint(v), 0x141, 0xf, 0xf, true)));
    v = fmaxf(v, __uint_as_float(__builtin_amdgcn_mov_dpp(__float_as_uint(v), 0x140, 0xf, 0xf, true)));
    return v;
}
__device__ __forceinline__ void peer_phase(const Params& P, unsigned char* lds_raw, int it0, int it1) {
    const int tid = opaque_tid(), wave = __builtin_amdgcn_readfirstlane(tid >> 6);
    const int gw = blockIdx.x * NWAVES + wave, NGW = gridDim.x * NWAVES;
    unsigned char* ws = P.ws;
    LAS unsigned char* lds = (LAS unsigned char*)lds_raw;
    stage_keys(P, lds);
    LAS int* e_w = (LAS int*)(lds + 32768 + wave * 5120); LAS float* g_w = (LAS float*)(e_w + 512); LAS float* a_l = g_w + 512; LAS float* s_l = a_l + 128;
    const bf16_t* qp = (const bf16_t*)(ws + WS_R_ZRX);
    const bf16_t* xn = (const bf16_t*)(ws + WS_R_XB); const unsigned char* UT = ws + WS_TAB; const unsigned char* VT = UT + (size_t)16384 * 768;
    const float* SU = (const float*)(ws + WS_PSCALE); const float* SV = SU + 16384;
    bf16_t* xn3 = (bf16_t*)(ws + WS_R_OB); float* hout = P.out; const float* gple = P.in[I_NORM_PLE];
    for (int it = it0; it < it1; ++it) { const int item = gw + it * NGW; if (item >= T / 4) break;
      topk_item(qp, lds, item, e_w, g_w);
      LDS_WAIT();
      for (int tl = 0; tl < 4; ++tl) {
        const int lane = opaque_tid() & 63, li = lane & 15, q = lane >> 4;
        const int tok = item * 4 + tl; LAS int* e_l = e_w + tl * 128; LAS float* g_l = g_w + tl * 128;
        { const int ea = e_l[lane], eb = e_l[lane + 64]; const float ga = g_l[lane], gb = g_l[lane + 64]; const int sa = ea >> 10, sb = eb >> 10;
          const float sua = SU[ea], sub_ = SU[eb], sva = SV[ea], svb = SV[eb];
          int pa = 0, pb = 0, base = 0;
#pragma unroll
          for (int b = 0; b < 16; ++b) { const unsigned long long ma = __ballot(sa == b), mb = __ballot(sb == b);
              const int ca = __builtin_popcountll(ma), cb = __builtin_popcountll(mb);
              const int ra = (int)__builtin_amdgcn_mbcnt_hi((unsigned)(ma >> 32), __builtin_amdgcn_mbcnt_lo((unsigned)ma, 0u)), rb = (int)__builtin_amdgcn_mbcnt_hi((unsigned)(mb >> 32), __builtin_amdgcn_mbcnt_lo((unsigned)mb, 0u));
              pa = (sa == b) ? base + ra : pa; pb = (sb == b) ? base + ca + rb : pb; base += ca + cb; }
          LDS_WAIT();
          e_l[pa] = ea; g_l[pa] = ga * sva; s_l[pa] = sua; e_l[pb] = eb; g_l[pb] = gb * svb; s_l[pb] = sub_; }
        f32x2 xf[32];
#pragma unroll
        for (int k = 0; k < 4; ++k) { const u32x4 a = *(const u32x4*)(xn + (size_t)tok * 1024 + (li + 16 * k) * 16), b = *(const u32x4*)(xn + (size_t)tok * 1024 + (li + 16 * k) * 16 + 8);
#pragma unroll
            for (int w = 0; w < 4; ++w) { xf[k * 8 + w] = (f32x2){bf_lo(a[w]), bf_hi(a[w])}; xf[k * 8 + 4 + w] = (f32x2){bf_lo(b[w]), bf_hi(b[w])}; } }
        LDS_WAIT();
        u32x4 cu[3], nu[3];
#define ROWLOAD(DST, TAB, R) do { const unsigned char* rp_ = (TAB) + (size_t)e_l[(R) * 4 + q] * 768 + li * 16; _Pragma("unroll") for (int k_ = 0; k_ < 3; ++k_) DST[k_] = *(const u32x4*)(rp_ + 256 * k_); } while (0)
#define DEC_A(C) __builtin_amdgcn_cvt_scalef32_pk32_f32_fp6((u32x6){C[0][0], C[0][1], C[0][2], C[0][3], C[1][0], C[1][1]}, 1.0f)
#define DEC_B(C) __builtin_amdgcn_cvt_scalef32_pk32_f32_fp6((u32x6){C[1][2], C[1][3], C[2][0], C[2][1], C[2][2], C[2][3]}, 1.0f)
        ROWLOAD(cu, UT, 0);
        for (int r = 0; r < 32; ++r) {
            if (r + 1 < 32) ROWLOAD(nu, UT, r + 1);
            f32x2 d0 = {0.f, 0.f}, d1 = {0.f, 0.f};
            { const f32x32 va = DEC_A(cu);
#pragma unroll
              for (int j = 0; j < 16; j += 2) { d0 = __builtin_elementwise_fma(xf[j], (f32x2){va[2 * j], va[2 * j + 1]}, d0); d1 = __builtin_elementwise_fma(xf[j + 1], (f32x2){va[2 * j + 2], va[2 * j + 3]}, d1); } }
            { const f32x32 vb = DEC_B(cu);
#pragma unroll
              for (int j = 0; j < 16; j += 2) { d0 = __builtin_elementwise_fma(xf[16 + j], (f32x2){vb[2 * j], vb[2 * j + 1]}, d0); d1 = __builtin_elementwise_fma(xf[17 + j], (f32x2){vb[2 * j + 2], vb[2 * j + 3]}, d1); } }
            const float d = dpp_sum16((d0.x + d0.y) + (d1.x + d1.y)) * s_l[r * 4 + q];
            if (li == 0) a_l[r * 4 + q] = gelu_tanh(d) * g_l[r * 4 + q];
#pragma unroll
            for (int k = 0; k < 3; ++k) cu[k] = nu[k];
        }
        LDS_WAIT();
        f32x2 acc2[32];
#pragma unroll
        for (int i = 0; i < 32; ++i) acc2[i] = (f32x2){0.f, 0.f};
        ROWLOAD(cu, VT, 0);
        for (int r = 0; r < 32; ++r) {
            if (r + 1 < 32) ROWLOAD(nu, VT, r + 1);
            const float a = a_l[r * 4 + q]; const f32x2 a2 = {a, a};
            { const f32x32 va = DEC_A(cu);
#pragma unroll
              for (int j = 0; j < 16; ++j) acc2[j] = __builtin_elementwise_fma(a2, (f32x2){va[2 * j], va[2 * j + 1]}, acc2[j]); }
            { const f32x32 vb = DEC_B(cu);
#pragma unroll
              for (int j = 0; j < 16; ++j) acc2[16 + j] = __builtin_elementwise_fma(a2, (f32x2){vb[2 * j], vb[2 * j + 1]}, acc2[16 + j]); }
#pragma unroll
            for (int k = 0; k < 3; ++k) cu[k] = nu[k];
        }
#undef ROWLOAD
#undef DEC_A
#undef DEC_B
        float acc[64];
#pragma unroll
        for (int i = 0; i < 32; ++i) { acc[2 * i] = acc2[i].x; acc[2 * i + 1] = acc2[i].y; }
        float fsum[16];
#pragma unroll
        for (int i = 0; i < 16; ++i) {
            auto r0 = __builtin_amdgcn_permlane32_swap(__float_as_uint(acc[i]), __float_as_uint(acc[i + 32]), false, false);
            auto r1 = __builtin_amdgcn_permlane32_swap(__float_as_uint(acc[i + 16]), __float_as_uint(acc[i + 48]), false, false);
            const float t0 = __uint_as_float(r0[0]) + __uint_as_float(r0[1]), t1 = __uint_as_float(r1[0]) + __uint_as_float(r1[1]);
            auto r2 = __builtin_amdgcn_permlane16_swap(__float_as_uint(t0), __float_as_uint(t1), false, false);
            fsum[i] = __uint_as_float(r2[0]) + __uint_as_float(r2[1]); }
        float ss = 0.f; float hv[16];
        { float* hp = hout + (size_t)tok * 1024 + (li + 16 * q) * 16;
#pragma unroll
            for (int c4 = 0; c4 < 4; ++c4) { const f32x4 h4 = *(const f32x4*)(hp + 4 * c4);
#pragma unroll
                for (int e = 0; e < 4; ++e) { hv[c4 * 4 + e] = h4[e] + fsum[c4 * 4 + e]; ss += hv[c4 * 4 + e] * hv[c4 * 4 + e]; }
                *(f32x4*)(hp + 4 * c4) = (f32x4){hv[c4 * 4], hv[c4 * 4 + 1], hv[c4 * 4 + 2], hv[c4 * 4 + 3]}; } }
        ss = wave_sum(ss);
        const float rs = 1.0f / sqrtf(ss * (1.0f / 1024.0f) + EPS);
        { const int dim = (li + 16 * q) * 16;
#pragma unroll
          for (int c8 = 0; c8 < 2; ++c8) { const f32x4 g0 = *(const f32x4*)(gple + dim + 8 * c8), g1 = *(const f32x4*)(gple + dim + 8 * c8 + 4);
              u32x4 w; w.x = cvt_pk_bf16(hv[8 * c8] * rs * g0[0], hv[8 * c8 + 1] * rs * g0[1]); w.y = cvt_pk_bf16(hv[8 * c8 + 2] * rs * g0[2], hv[8 * c8 + 3] * rs * g0[3]);
              w.z = cvt_pk_bf16(hv[8 * c8 + 4] * rs * g1[0], hv[8 * c8 + 5] * rs * g1[1]); w.w = cvt_pk_bf16(hv[8 * c8 + 6] * rs * g1[2], hv[8 * c8 + 7] * rs * g1[3]);
              *(u32x4*)(xn3 + (size_t)tok * 1024 + dim + 8 * c8) = w; } }
        LDS_WAIT();
      }
    }
    __syncthreads();
}
}
constexpr int LDS_BYTES = 135168 + 256 + 256 + 1024;
static_assert(att::LDS_BYTES <= LDS_BYTES && LRU_END <= LDS_BYTES, "LDS budget");

__device__ __forceinline__ att::Blk make_blk(unsigned char* ws, int L, int sub, int G) {
    int bg, pair; if (G == 256) { bg = (L & 7) * 2 + (L >> 8); pair = (L >> 3) & 31; } else { bg = L >> 5; pair = L & 31; }
    const int qt = (sub < 3) ? (63 - pair) : pair, mode = sub % 3, b = bg >> 1, g = bg & 1, t0 = qt * 64;
    const size_t rowoff = (size_t)(b * S + t0) * 1024 + g * 512;
    att::Blk k;
    k.Q = (const bf16_t*)(ws + (mode == 0 ? WS_R_Q : WS_R_ZRX)) + rowoff; k.O = (bf16_t*)(ws + WS_R_OB) + rowoff;
    if (mode == 0) { k.K = (const bf16_t*)(ws + WS_KC) + (size_t)bg * 256 * 128; k.V = k.K + (size_t)16 * 256 * 128; }
    else { k.K = (const bf16_t*)(ws + WS_R_KV) + (size_t)(2 * mode * 16 + bg) * S * 128; k.V = k.K + (size_t)16 * S * 128; }
    k.gate = (const float*)(ws + WS_GATES) + (size_t)(b * S + t0) * 24 + g * 12 + mode;
    k.sel = (const unsigned*)(ws + WS_SEL) + ((size_t)(b * S + t0) * 2 + g) * 2;
    k.t0 = t0; k.mode = mode;
    const int lowk = t0 - att::WINDOW_W + 1;
    k.jlo = (mode == 2 && lowk > 0) ? lowk / 64 : 0;
    k.NT = mode == 0 ? ((((t0 + 63) - 31) >> 4) >> 6) + 1 : qt + 1 - k.jlo;
    return k;
}


constexpr int NCONV_STEPS = 5;
__device__ __forceinline__ void convert_step(const Params& P, int step) {
    const int tid = opaque_tid(), bid = blockIdx.x, G = gridDim.x; unsigned char* ws = P.ws;
    if (step == 4) {
        const float* p = P.in[I_P]; bf16_t* pb = (bf16_t*)(ws + WS_PB);
        for (int i = bid * NTHREADS + tid; i < T * PLE / 8; i += G * NTHREADS) { const f32x4 a = ((const f32x4*)p)[2 * i], b = ((const f32x4*)p)[2 * i + 1]; ((u32x4*)pb)[i] = pack8(a, b); }
        return; }
    const int li = tid & 15; unsigned char* ut = ws + WS_TAB; float* sct = (float*)(ws + WS_PSCALE);
    for (int r = (step * G + bid) * 32 + (tid >> 4); r < 2 * 16384; r += 4 * G * 32) { const int which = r >> 14; const float* src = P.in[which ? I_PEER_V : I_PEER_U] + (size_t)(r & 16383) * 1024;
        f32x4 v[16]; float mx = 0.f;
#pragma unroll
        for (int k = 0; k < 4; ++k)
#pragma unroll
            for (int c4 = 0; c4 < 4; ++c4) { v[k * 4 + c4] = *(const f32x4*)(src + (li + 16 * k) * 16 + 4 * c4);
                mx = fmaxf(fmaxf(mx, fmaxf(fabsf(v[k * 4 + c4][0]), fabsf(v[k * 4 + c4][1]))), fmaxf(fabsf(v[k * 4 + c4][2]), fabsf(v[k * 4 + c4][3]))); }
        mx = peer::dpp_max16(mx);
        const float inv = mx > 0.f ? 7.5f / mx : 0.f;
        u32x4 w[3];
        { f32x16 a0, b0, a1, b1;
#pragma unroll
          for (int i = 0; i < 16; ++i) { a0[i] = v[i >> 1][(2 * i) & 3] * inv; b0[i] = v[i >> 1][(2 * i + 1) & 3] * inv; a1[i] = v[8 + (i >> 1)][(2 * i) & 3] * inv; b1[i] = v[8 + (i >> 1)][(2 * i + 1) & 3] * inv; }
          const u32x6 wa = __builtin_amdgcn_cvt_scalef32_2xpk16_fp6_f32(a0, b0, 1.0f), wb = __builtin_amdgcn_cvt_scalef32_2xpk16_fp6_f32(a1, b1, 1.0f);
          w[0] = (u32x4){wa[0], wa[1], wa[2], wa[3]}; w[1] = (u32x4){wa[4], wa[5], wb[0], wb[1]}; w[2] = (u32x4){wb[2], wb[3], wb[4], wb[5]}; }
        unsigned char* dst = ut + (size_t)r * 768 + li * 16;
#pragma unroll
        for (int k = 0; k < 3; ++k) *(u32x4*)(dst + 256 * k) = w[k];
        if (li == 0) sct[r] = mx * (1.0f / 7.5f); }
}

__global__ void __launch_bounds__(NTHREADS, 2) fwd_megakernel(const Params P_arg) {
#if defined(__HIP_DEVICE_COMPILE__)
    extern __shared__ __attribute__((aligned(16))) unsigned char lds[];
    cg::grid_group grid = cg::this_grid();
    const int G = gridDim.x, bid = blockIdx.x;
    LAS unsigned char* ldsl = (LAS unsigned char*)lds;
    volatile LAS unsigned* bar_st = (volatile LAS unsigned*)(ldsl + 135168 + 240);
    if (threadIdx.x < 4) bar_st[threadIdx.x] = 0u;
    ((volatile LAS int*)(uintptr_t)WID_LDS_OFF)[(unsigned)__builtin_amdgcn_s_getreg((5 << 11) | 4) & 0x3fu] = (int)(threadIdx.x >> 6);
    __syncthreads();
    XcdBarrier xbar;
    { typedef const __attribute__((address_space(4))) Params* kp_t; unsigned char* ws0 = ((kp_t)__builtin_amdgcn_kernarg_segment_ptr())->ws; xbar = xcd_barrier_post((unsigned*)(ws0 + WS_CTL), bar_st); }
    int n_sync = 0;
    if (G == 0x7fffffff) grid.sync();
#define GSYNC() do { xcd_barrier(xbar); ++n_sync; } while (0)
    typedef const __attribute__((address_space(4))) Params* kparams_t;
    const kparams_t Pk = (kparams_t)__builtin_amdgcn_kernarg_segment_ptr();
#define PH_BEGIN() kparams_t pp_ = Pk; asm volatile("" : "+s"(pp_)); const Params P = *pp_; unsigned char* ws = P.ws; (void)ws; \
                   const int tid = opaque_tid(); const int lane = tid & 63, wave = __builtin_amdgcn_readfirstlane(tid >> 6); \
                   const int gw = bid * NWAVES + wave, NGW = G * NWAVES; (void)lane; (void)gw; (void)NGW;

    { PH_BEGIN()
    phase0(P, lds);
    __syncthreads(); }
    GSYNC();
    { PH_BEGIN()
    {
        pg8::Gemm g{(const bf16_t*)(ws + WS_R_XB), (const bf16_t*)(ws + WS_WIN_T), T, 4864, 1024};
        pg8::StaticOrder so; so.init(T, 4864, G, bid);
        EpiZ E{(bf16_t*)(ws + WS_R_ZRX), (bf16_t*)(ws + WS_R_GZ), (bf16_t*)(ws + WS_R_Q), (bf16_t*)(ws + WS_R_KV), (float*)(ws + WS_GATES)};
        pg8::gemm_phase<EpiZ, pg8::StaticOrder, true, true>(ldsl, g, so, E);
    }
    if (G == 256) { if (bid >= 128) side_work(P, lds, (bid - 128) * NWAVES + wave, 128 * NWAVES); }
    else side_work(P, lds, gw, NGW);
    __syncthreads(); }
    GSYNC();
    { PH_BEGIN()
    {
    for (int cu = bid; cu < 256; cu += G) { const int j = cu >> 7, ks = (cu >> 5) & 3, tile = cu & 31;
        pg8::Gemm g{(const bf16_t*)(ws + WS_R_KV) + (size_t)j * 16 * S * 128 + ks * 512, (const bf16_t*)(ws + (j ? WS_W1V_T : WS_W1K_T)) + ks * 512, 4096, 512, 512, 2048, 2048};
        RangeOrder ro{2, tile, 1, 1, 0};
        EpiBf E{(bf16_t*)(ws + WS_G12P) + ((size_t)ks * 2 + j) * 4096 * 512, 512};
        pg8::gemm_phase<EpiBf, RangeOrder, true, true>(ldsl, g, ro, E); }
    }
    for (int unit = bid; unit < 256; unit += G) { int ub = unit >> 5, us = unit & 31;
        if (G == 256) { const int x = unit & 7, k = unit >> 3, grp = (k >> 2) * 8 + x; ub = grp >> 3; us = (grp & 7) * 4 + (k & 3); }
        lru_unit(P, lds, ub, us); }
    {
    rope_k_pass(P);
    }
    __syncthreads(); }
    GSYNC();
    { PH_BEGIN()
    compress_mlp2(P, lds);
    __syncthreads(); }
    GSYNC();
    { PH_BEGIN()
    if (bid & 1) rope_q_pass(P);
    for (int unit = bid; unit < 256; unit += G) att::imp_unit(P, (char*)lds, unit >> 4, unit & 15);
    if (!(bid & 1)) rope_q_pass(P);
    __syncthreads(); }
    GSYNC();
    { PH_BEGIN()
    int cstep = 0;
    if (bid < 512) {
        att::Seam Sm;
        int L = bid, sub = 0, nb = 0;
        att::Blk cur = make_blk(ws, L, 0, G);
        att::attn_prime(cur, (char*)lds, Sm);
        for (;;) {
            int Ln = L, subn = sub + 1; bool last = false;
            if (subn == 6) { subn = 0; Ln = L + G; if (Ln >= 512) { last = true; Ln = L; subn = sub; } }
            const att::Blk nxt = make_blk(ws, Ln, subn, G);
            att::attn_block(cur, nxt, (char*)lds, Sm);
            if ((nb & 1) && cstep < NCONV_STEPS) { convert_step(P, cstep); ++cstep; }
            ++nb;
            if (last) break;
            cur = nxt; L = Ln; sub = subn;
        }
    }
    for (; cstep < NCONV_STEPS; ++cstep) convert_step(P, cstep);
    __syncthreads(); }
    GSYNC();
    { PH_BEGIN()
    {
        pg8::StaticOrder so; so.init(T, 1024, G, bid);
        { pg8::Gemm g{(const bf16_t*)(ws + WS_R_GZ), (const bf16_t*)(ws + WS_WA_T), T, 1024, 1024}; EpiBf E{(bf16_t*)(ws + WS_R_ZRX), 1024};
          pg8::gemm_phase<EpiBf, pg8::StaticOrder, true, true>(ldsl, g, so, E); }
        { pg8::Gemm g{(const bf16_t*)(ws + WS_R_OB), (const bf16_t*)(ws + WS_WB_T), T, 1024, 1024}; EpiBf E{(bf16_t*)(ws + WS_R_KV), 1024};
          pg8::gemm_phase<EpiBf, pg8::StaticOrder, true, true>(ldsl, g, so, E); }
    }
    __syncthreads(); }
    GSYNC();
    { PH_BEGIN()
    {
        pg8::Gemm g{(const bf16_t*)(ws + WS_R_XB), (const bf16_t*)(ws + WS_WM_T), T, 2048, 1024};
        pg8::StaticOrder so; so.init(T, 2048, G, bid);
        EpiMerge E{(const bf16_t*)(ws + WS_R_ZRX), (const bf16_t*)(ws + WS_R_KV), (bf16_t*)(ws + WS_R_GZ)};
        pg8::gemm_phase<EpiMerge, pg8::StaticOrder, true, true>(ldsl, g, so, E);
    }
    __syncthreads(); }
    GSYNC();
    { PH_BEGIN()
    {
        pg8::Gemm g{(const bf16_t*)(ws + WS_R_GZ), (const bf16_t*)(ws + WS_WOUT_T), T, 1024, 1024};
        EpiResidNorm E{P.in[I_X], P.out, (bf16_t*)(ws + WS_R_XB), P.in[I_NORM_FFN], (unsigned*)(ws + WS_SSQ) + T * 4, (unsigned*)(ws + WS_CTL), ldsl, 32u};
        PanelOrder po;
        if (G == 256) { const int x = bid & 7, k = bid >> 3; po.pm = x * 8 + (k >> 2); po.pn = k & 3; po.dpm = 64; po.n = 2; }
        else { const int Gr = G >= 512 ? 512 : (G & ~3); po.pm = bid >> 2; po.pn = bid & 3; po.dpm = Gr >> 2; po.n = (bid < Gr) ? (512 - bid + Gr - 1) / Gr : 0; }
        pg8::gemm_phase<EpiResidNorm, PanelOrder, true, true>(ldsl, g, po, E);
    }
    __syncthreads(); }
    GSYNC();
    { PH_BEGIN()
    {
        pg8::StaticOrder so; so.init(T, 1024, G, bid);
        { pg8::Gemm g{(const bf16_t*)(ws + WS_R_XB), (const bf16_t*)(ws + WS_WQ_T), T, 1024, 1024}; EpiBf E{(bf16_t*)(ws + WS_R_ZRX), 1024};
          pg8::gemm_phase<EpiBf, pg8::StaticOrder, true, true>(ldsl, g, so, E); }
    }
    __syncthreads(); }
    GSYNC();
    { PH_BEGIN()
    const int nit = (T / 4 + NGW - 1) / NGW, mid = (bid & 1) ? (nit + 1) / 2 : 0;
    if (mid > 0) peer::peer_phase(P, lds, 0, mid);
    { pg8::Gemm g{(const bf16_t*)(ws + WS_PB), (const bf16_t*)(ws + WS_WP_T), T, 1024, 256}; EpiBf E{(bf16_t*)(ws + WS_R_GZ), 1024};
      RangeOrder ro{4, 0, 512, G, bid};
      pg8::gemm_phase<EpiBf, RangeOrder, true, true>(ldsl, g, ro, E);
      __syncthreads(); }
    peer::peer_phase(P, lds, mid, nit);
    __syncthreads(); }
    GSYNC();
    { PH_BEGIN()
    {
        pg8::Gemm g{(const bf16_t*)(ws + WS_R_OB), (const bf16_t*)(ws + WS_WG_T), T, 1024, 1024};
        EpiPleNorm E{P.out, (const bf16_t*)(ws + WS_R_GZ), P.in[I_NORM_FINAL], (unsigned*)(ws + WS_SSQ), (unsigned*)(ws + WS_CTL), ldsl, 64u};
        PanelOrder po;
        if (G == 256) { const int x = bid & 7, k = bid >> 3; po.pm = x * 8 + (k >> 2); po.pn = k & 3; po.dpm = 64; po.n = 2; }
        else { const int Gr = G >= 512 ? 512 : (G & ~3); po.pm = bid >> 2; po.pn = bid & 3; po.dpm = Gr >> 2; po.n = (bid < Gr) ? (512 - bid + Gr - 1) / Gr : 0; }
        pg8::gemm_phase<EpiPleNorm, PanelOrder, true, true>(ldsl, g, po, E);
    }
    __syncthreads(); }
#endif
}

extern "C" void kernel_launch(void* const* d_in, const int* in_sizes, int n_in, void* d_out, int out_size, void* d_ws, size_t ws_size, hipStream_t stream) {
    static int grid_blocks = 0;
    if (grid_blocks == 0) {
        if (n_in != 34 || out_size != T * D || ws_size < WS_END) { fprintf(stderr, "kernel_launch: unexpected shapes (n_in %d out %d ws %zu)\n", n_in, out_size, ws_size); grid_blocks = -1; return; }
        int dev = 0, cus = 0, per_cu = 0;
        (void)hipGetDevice(&dev);
        (void)hipDeviceGetAttribute(&cus, hipDeviceAttributeMultiprocessorCount, dev);
        if (hipFuncSetAttribute((const void*)fwd_megakernel, hipFuncAttributeMaxDynamicSharedMemorySize, LDS_BYTES) != hipSuccess) { fprintf(stderr, "kernel_launch: hipFuncSetAttribute failed\n"); grid_blocks = -1; return; }
        (void)hipOccupancyMaxActiveBlocksPerMultiprocessor(&per_cu, (const void*)fwd_megakernel, NTHREADS, LDS_BYTES);
        if (per_cu < 1 || cus < 1) { fprintf(stderr, "kernel_launch: occupancy query says %d blocks per CU (%d CUs)\n", per_cu, cus); grid_blocks = -1; return; }
        grid_blocks = cus;
    }
    if (grid_blocks < 0) return;
    Params p{};
    for (int i = 0; i < 34; ++i) p.in[i] = (const float*)d_in[i];
    p.out = (float*)d_out; p.ws = (unsigned char*)d_ws;
    (void)hipMemsetAsync((char*)d_ws + WS_CTL, 0, 65536, stream);
    void* args[] = {&p};
    hipError_t e = hipLaunchCooperativeKernel((const void*)fwd_megakernel, dim3(grid_blocks), dim3(NTHREADS), args, LDS_BYTES, stream);
    if (e != hipSuccess) fprintf(stderr, "cooperative launch failed: %s (grid %d)\n", hipGetErrorString(e), grid_blocks);
}
```

```cpp
#include <hip/hip_runtime.h>
#include <hip/hip_cooperative_groups.h>
#include <cstdio>
#include <cstdint>
namespace cg = cooperative_groups;

#define LAS __attribute__((address_space(3)))
typedef unsigned short bf16_t;
typedef short bf16x8 __attribute__((ext_vector_type(8)));
typedef short s16x4 __attribute__((ext_vector_type(4)));
typedef float f32x2 __attribute__((ext_vector_type(2)));
typedef float f32x4 __attribute__((ext_vector_type(4)));
typedef float f32x16 __attribute__((ext_vector_type(16)));
typedef unsigned u32x2 __attribute__((ext_vector_type(2)));
typedef unsigned u32x4 __attribute__((ext_vector_type(4)));
typedef __bf16 bf16x2_t __attribute__((ext_vector_type(2)));
typedef unsigned u32x6 __attribute__((ext_vector_type(6)));
typedef float f32x32 __attribute__((ext_vector_type(32)));
typedef unsigned long long u64;

constexpr int NB = 8, S = 4096, T = NB * S, D = 1024, DIN = 6680, PLE = 256;
constexpr int NGRP = 2, HD = 128, NSELB = 64, NCMP = 255;
constexpr int NTHREADS = 512, NWAVES = 8;
constexpr float EPS = 1e-6f;
constexpr float LOG2E = 1.4426950408889634f;
constexpr float ATT_SCALE = 0.08838834764831845f;

constexpr size_t MiB = 1ull << 20;
constexpr size_t WS_CTL    = 0;
constexpr size_t WS_WIN_T  = 1 * MiB;
constexpr size_t WS_WA_T   = 11 * MiB;
constexpr size_t WS_WB_T   = 13 * MiB;
constexpr size_t WS_WM_T   = 15 * MiB;
constexpr size_t WS_WOUT_T = 19 * MiB;
constexpr size_t WS_WQ_T   = 21 * MiB;
constexpr size_t WS_WG_T   = 23 * MiB;
constexpr size_t WS_WP_T   = 25 * MiB;
constexpr size_t WS_W1K_T  = 26 * MiB;
constexpr size_t WS_W1V_T  = 28 * MiB;
constexpr size_t WS_LRUW   = 30 * MiB;
constexpr size_t WS_COS    = 31 * MiB;
constexpr size_t WS_SIN    = 39 * MiB;
constexpr size_t WS_C1P    = 47 * MiB;
constexpr size_t WS_RS3    = 47 * MiB + 768 * 1024;
constexpr size_t WS_RS2    = 47 * MiB + 896 * 1024;
constexpr size_t WS_PSCALE = 47 * MiB + 512 * 1024;
constexpr size_t WS_GATES  = 48 * MiB;
constexpr size_t WS_SEL    = 51 * MiB;
constexpr size_t WS_KC     = 52 * MiB;
constexpr size_t WS_W2T    = 54 * MiB;
constexpr size_t WS_R_XB   = 55 * MiB;
constexpr size_t WS_R_ZRX  = 119 * MiB;
constexpr size_t WS_R_GZ   = 183 * MiB;
constexpr size_t WS_R_Q    = 247 * MiB;
constexpr size_t WS_R_KV   = 311 * MiB;
constexpr size_t WS_R_OB   = 407 * MiB;
constexpr size_t WS_HB     = WS_R_Q;
constexpr size_t WS_G12P   = WS_R_OB;
constexpr size_t WS_PB     = 496 * MiB;
constexpr size_t WS_SSQ    = 471 * MiB;
constexpr size_t WS_TAB    = 472 * MiB;
constexpr size_t WS_END    = 512 * MiB;

__device__ __forceinline__ unsigned cvt_pk_bf16(float lo, float hi) { unsigned r; asm("v_cvt_pk_bf16_f32 %0, %1, %2" : "=v"(r) : "v"(lo), "v"(hi)); return r; }
__device__ __forceinline__ float bf_lo(unsigned u) { return __uint_as_float(u << 16); }
__device__ __forceinline__ float bf_hi(unsigned u) { return __uint_as_float(u & 0xffff0000u); }
__device__ __forceinline__ float fast_exp2(float x) { return __builtin_amdgcn_exp2f(x); }
__device__ __forceinline__ float fast_rcp(float x) { return __builtin_amdgcn_rcpf(x); }
__device__ __forceinline__ float sigmoidf_(float x) { return fast_rcp(1.f + fast_exp2(-x * LOG2E)); }
__device__ __forceinline__ float gelu_tanh(float x) { const float y = 1.5957691216057308f * (x + 0.044715f * x * x * x); return x * fast_rcp(1.f + fast_exp2(-y * LOG2E)); }
__device__ __forceinline__ f32x2 sigmoid2(f32x2 x) {
    const f32x2 k = {-LOG2E, -LOG2E}, one = {1.f, 1.f}; const f32x2 a = x * k;
    f32x2 e = {fast_exp2(a.x), fast_exp2(a.y)}; e = e + one; return (f32x2){fast_rcp(e.x), fast_rcp(e.y)}; }
__device__ __forceinline__ float wave_sum(float v) {
#pragma unroll
    for (int o = 1; o < 64; o <<= 1) v += __shfl_xor(v, o);
    return v;
}
constexpr int WID_LDS_OFF = 135168 + 256;
__device__ __forceinline__ int opaque_tid() {
    const unsigned slot = (unsigned)__builtin_amdgcn_s_getreg((5 << 11) | 4) & 0x3fu;
    const int w = __builtin_amdgcn_readfirstlane(((const volatile LAS int*)(uintptr_t)WID_LDS_OFF)[slot]);
    unsigned z = 0u; asm volatile("" : "+v"(z));
    int t = w * 64 + (int)__builtin_amdgcn_mbcnt_hi(~0u, __builtin_amdgcn_mbcnt_lo(~0u, z));
    asm volatile("" : "+v"(t)); return t; }
#define LDS_WAIT() asm volatile("s_waitcnt lgkmcnt(0)" ::: "memory")
#define VM_WAIT() asm volatile("s_waitcnt vmcnt(0)" ::: "memory")

struct Params {
    const float* in[34];
    float* out;
    unsigned char* ws;
};
enum { I_X = 0, I_P, I_POS, I_NORM_MIX, I_W_IN, I_CONV_W, I_CONV_B, I_LRU_WR, I_LRU_BR, I_LRU_WI, I_LRU_BI, I_LRU_LAM,
       I_PE_K, I_W1_K, I_B1_K, I_W2_K, I_B2_K, I_PE_V, I_W1_V, I_B1_V, I_W2_V, I_B2_V,
       I_W_A, I_W_B, I_W_OUT, I_NORM_FFN, I_PEER_WQ, I_PEER_KEYS, I_PEER_U, I_PEER_V, I_NORM_PLE, I_PLE_WG, I_PLE_WP, I_NORM_FINAL };
namespace pg8 {
#define PG8_LAS LAS
typedef short bf16x8 __attribute__((ext_vector_type(8)));
typedef float f32x4 __attribute__((ext_vector_type(4)));
typedef unsigned u32x4 __attribute__((ext_vector_type(4)));
constexpr int BM = 256, BK = 64, HALF = 128, HTB = HALF * BK * 2  , STAGE_BYTES = 8 * HTB, NXCD = 8, WGM = 8;

__host__ __device__ __forceinline__ int lds_byte(int r, int c) { const int st = (r >> 4) * 2 + (c >> 5), rr = r & 15, cc = c & 31, ob = rr * 64 + cc * 2; return st * 1024 + (ob ^ (((ob >> 9) & 1) << 5)); }
__host__ __device__ __forceinline__ void stage_rc(int b, int& R, int& C) { const int st = b / 1024, sb = b % 1024, swz = sb ^ (((sb >> 9) & 1) << 5); R = (st >> 1) * 16 + swz / 64; C = (st & 1) * 32 + (swz % 64) / 2; }
__host__ __device__ __forceinline__ int perm32(int rho) { const int n = rho >> 4, i = rho & 15; return 8 * (i >> 2) + 4 * n + (i & 3); }

struct Unit { int pm, pn; };
struct Gemm { const bf16_t* A; const bf16_t* Bt; int M, N, K; int lda = 0, ldb = 0; };

struct StaticOrder {
    int nM, nN, nwg, G, c;
    __host__ __device__ void init(int M, int N, int G_, int c_) { nM = M / BM; nN = N / BM; nwg = nM * nN; G = G_; c = c_; }
    __host__ __device__ bool next(int i, Unit& u) const {
        const long L = (long)i * G + c; if (L >= nwg) return false;
        int wgid = (int)L; { const int q = nwg / NXCD, r = nwg % NXCD, xcd = wgid % NXCD, off = wgid / NXCD; wgid = (xcd < r ? xcd * (q + 1) : r * (q + 1) + (xcd - r) * q) + off; }
        const int nig = WGM * nN, gid = wgid / nig, fm = gid * WGM, gsz = (nM - fm) < WGM ? (nM - fm) : WGM;
        u.pm = fm + ((wgid % nig) % gsz); u.pn = (wgid % nig) / gsz; return true;
    }
    __device__ __forceinline__ void a_ready(const Unit&) const {}
    __device__ __forceinline__ void done(const Unit&) const {}
};
template <class Epi, class Sched, bool ALIGN_EPI = false, bool SP2 = false>
__device__ __forceinline__ void gemm_phase(PG8_LAS unsigned char* lds, const Gemm g, const Sched& S, const Epi& E) {
    const int tid = opaque_tid(), wid = __builtin_amdgcn_readfirstlane(tid >> 6), lane = tid & 63, wr = wid >> 2, wc = wid & 3, fr = lane & 15, fq = lane >> 4;
    const int K = g.K, nt = K / BK, lda = g.lda ? g.lda : K, ldb = g.ldb ? g.ldb : K;
    unsigned voffA[2], voffB[2];
#pragma unroll
    for (int i = 0; i < 2; ++i) { int R, C; stage_rc(tid * 16 + i * 8192, R, C); const int Rb = Epi::PERM ? ((R & ~31) + perm32(R & 31)) : R;
        voffA[i] = (unsigned)(R * lda + C) * 2u; voffB[i] = (unsigned)(Rb * ldb + C) * 2u; }
    const size_t kstep = (size_t)(BK * 2);
    const size_t hA = (size_t)HALF * lda * 2, hB = (size_t)HALF * ldb * 2;
    const size_t tA = 2 * hA, tB = 2 * hB;
    const unsigned ldsw = (unsigned)wid * 1024u;
    const int aoff = lds_byte(wr * 64 + fr, fq * 8), boff = lds_byte(wc * 32 + fr, fq * 8);
#define PG8_SA(b, h) (((b) * 2 + (h)) * HTB)
#define PG8_SB(b, h) ((4 + (b) * 2 + (h)) * HTB)
#define PG8_STAGE(bufoff, gbase, voff) do { _Pragma("unroll") for (int _i = 0; _i < 2; ++_i) \
        __builtin_amdgcn_global_load_lds((const unsigned*)((const char*)(gbase) + (voff)[_i]), (PG8_LAS unsigned*)(lds + (bufoff) + ldsw + _i * 8192), 16, 0, 0); } while (0)
#define PG8_LDA(dst, b, h) do { _Pragma("unroll") for (int m = 0; m < 4; ++m) _Pragma("unroll") for (int k = 0; k < 2; ++k) dst[m][k] = *(const PG8_LAS bf16x8*)(lds + PG8_SA(b, h) + aoff + m * 2048 + k * 1024); } while (0)
#define PG8_LDB(dst, b, h) do { _Pragma("unroll") for (int n = 0; n < 2; ++n) _Pragma("unroll") for (int k = 0; k < 2; ++k) dst[n][k] = *(const PG8_LAS bf16x8*)(lds + PG8_SB(b, h) + boff + n * 2048 + k * 1024); } while (0)
#define PG8_MMA(ai, bj, At, Bt) do { __builtin_amdgcn_s_setprio(1); _Pragma("unroll") for (int m = 0; m < 4; ++m) _Pragma("unroll") for (int n = 0; n < 2; ++n) _Pragma("unroll") for (int k = 0; k < 2; ++k) \
        acc[ai][bj][m][n] = __builtin_amdgcn_mfma_f32_16x16x32_bf16(Bt[n][k], At[m][k], acc[ai][bj][m][n], 0, 0, 0); __builtin_amdgcn_s_setprio(0); } while (0)
#define PG8_WAIT_V(n) asm volatile("s_waitcnt vmcnt(" #n ")" ::: "memory")
#define PG8_WAIT_L(n) asm volatile("s_waitcnt lgkmcnt(" #n ")" ::: "memory")
#define PG8_WAIT_VX do { if constexpr (Epi::MIN_VM == 0) PG8_WAIT_V(8); else asm volatile("s_waitcnt vmcnt(%1)\n\ts_cmp_lg_u32 %0, 0\n\ts_cbranch_scc1 1f\n\ts_waitcnt vmcnt(8)\n1:" :: "s"(fx), "i"(8 + Epi::MIN_VM) : "memory", "scc"); } while (0)
#define PG8_BAR __builtin_amdgcn_s_barrier()
#define PG8_SCHED __builtin_amdgcn_sched_barrier(0)
    Unit cur, nxt; int ui = 0; bool rlx = false;
    if (!S.next(0, cur)) return;
    f32x4 acc[2][2][4][2];
#pragma unroll
    for (int a = 0; a < 2; ++a)
#pragma unroll
        for (int b = 0; b < 2; ++b)
#pragma unroll
            for (int m = 0; m < 4; ++m)
#pragma unroll
                for (int n = 0; n < 2; ++n) acc[a][b][m][n] = (f32x4){0.f, 0.f, 0.f, 0.f};
    bf16x8 At[4][2], B0[2][2], B1[2][2];
    const char* cA = (const char*)g.A + (size_t)cur.pm * tA; const char* cB = (const char*)g.Bt + (size_t)cur.pn * tB;
    S.a_ready(cur);
    if constexpr (SP2) {
        PG8_STAGE(PG8_SB(0, 0), cB, voffB); PG8_STAGE(PG8_SB(0, 1), cB + hB, voffB); PG8_STAGE(PG8_SA(0, 0), cA, voffA); PG8_STAGE(PG8_SA(0, 1), cA + hA, voffA);
        if (wr == 1) PG8_BAR;
        PG8_WAIT_V(2); PG8_BAR;
        PG8_STAGE(PG8_SB(1, 0), cB + kstep, voffB); PG8_STAGE(PG8_SA(1, 0), cA + kstep, voffA); PG8_STAGE(PG8_SB(1, 1), cB + hB + kstep, voffB);
        PG8_WAIT_V(6); PG8_BAR;
    } else {
        PG8_STAGE(PG8_SB(0, 0), cB, voffB); PG8_STAGE(PG8_SA(0, 0), cA, voffA); PG8_STAGE(PG8_SB(0, 1), cB + hB, voffB); PG8_STAGE(PG8_SA(0, 1), cA + hA, voffA);
        if (wr == 1) PG8_BAR;
        PG8_WAIT_V(4); PG8_BAR;
        PG8_STAGE(PG8_SB(1, 0), cB + kstep, voffB); PG8_STAGE(PG8_SA(1, 0), cA + kstep, voffA); PG8_STAGE(PG8_SB(1, 1), cB + hB + kstep, voffB);
        PG8_WAIT_V(6); PG8_BAR;
    }
    for (;;) {
        const bool has_next = S.next(ui + 1, nxt);
        const char* nA = has_next ? (const char*)g.A + (size_t)nxt.pm * tA : cA; const char* nB = has_next ? (const char*)g.Bt + (size_t)nxt.pn * tB : cB;
        for (int t = 0; t < nt; t += 2) {
            const bool last = (t == nt - 2);
            const char* a1 = cA + (size_t)(t + 1) * kstep;
            const char* a2 = last ? nA : cA + (size_t)(t + 2) * kstep; const char* b2 = last ? nB : cB + (size_t)(t + 2) * kstep;
            const char* a3 = a2 + kstep; const char* b3 = b2 + kstep;
            if (last && has_next) S.a_ready(nxt);
            if constexpr (SP2) {
            const int fx = __builtin_amdgcn_readfirstlane((t == 0 && rlx) ? 1 : 0);
            PG8_LDB(B0, 0, 0); PG8_LDB(B1, 0, 1); PG8_SCHED; PG8_LDA(At, 0, 0); PG8_STAGE(PG8_SA(1, 1), a1 + hA, voffA);
            PG8_WAIT_VX; PG8_WAIT_L(0); PG8_BAR; PG8_MMA(0, 0, At, B0); PG8_MMA(0, 1, At, B1); PG8_BAR; PG8_SCHED;
            PG8_LDA(At, 0, 1); PG8_STAGE(PG8_SB(0, 0), b2, voffB); PG8_STAGE(PG8_SB(0, 1), b2 + hB, voffB); PG8_STAGE(PG8_SA(0, 0), a2, voffA);
            PG8_WAIT_VX; PG8_WAIT_L(0); PG8_BAR; PG8_MMA(1, 0, At, B0); PG8_MMA(1, 1, At, B1); PG8_BAR; PG8_SCHED;
            PG8_LDB(B0, 1, 0); PG8_LDB(B1, 1, 1); PG8_SCHED; PG8_LDA(At, 1, 0); PG8_STAGE(PG8_SA(0, 1), a2 + hA, voffA);
            PG8_WAIT_VX; PG8_WAIT_L(0); PG8_BAR; PG8_MMA(0, 0, At, B0); PG8_MMA(0, 1, At, B1); PG8_BAR; PG8_SCHED;
            PG8_LDA(At, 1, 1); PG8_STAGE(PG8_SB(1, 0), b3, voffB); PG8_STAGE(PG8_SB(1, 1), b3 + hB, voffB); PG8_STAGE(PG8_SA(1, 0), a3, voffA);
            PG8_WAIT_V(8); PG8_WAIT_L(0); PG8_BAR; PG8_MMA(1, 0, At, B0); PG8_MMA(1, 1, At, B1); PG8_BAR; PG8_SCHED;
            } else {
            PG8_LDB(B0, 0, 0); PG8_SCHED; PG8_LDA(At, 0, 0); PG8_STAGE(PG8_SA(1, 1), a1 + hA, voffA);
            PG8_WAIT_L(8); PG8_BAR; PG8_WAIT_L(0); PG8_MMA(0, 0, At, B0); PG8_BAR; PG8_SCHED;
            PG8_LDB(B1, 0, 1); PG8_STAGE(PG8_SB(0, 0), b2, voffB);
            PG8_BAR; PG8_WAIT_L(0); PG8_MMA(0, 1, At, B1); PG8_BAR;
            PG8_LDA(At, 0, 1); PG8_STAGE(PG8_SA(0, 0), a2, voffA);
            PG8_BAR; PG8_WAIT_L(0); PG8_MMA(1, 0, At, B0); PG8_BAR; PG8_SCHED;
            PG8_STAGE(PG8_SB(0, 1), b2 + hB, voffB);
            PG8_WAIT_V(6); PG8_BAR; PG8_MMA(1, 1, At, B1); PG8_BAR;
            PG8_LDB(B0, 1, 0); PG8_SCHED; PG8_LDA(At, 1, 0); PG8_STAGE(PG8_SA(0, 1), a2 + hA, voffA);
            PG8_WAIT_L(8); PG8_BAR; PG8_WAIT_L(0); PG8_MMA(0, 0, At, B0); PG8_BAR; PG8_SCHED;
            PG8_LDB(B1, 1, 1); PG8_STAGE(PG8_SB(1, 0), b3, voffB);
            PG8_BAR; PG8_WAIT_L(0); PG8_MMA(0, 1, At, B1); PG8_BAR;
            PG8_LDA(At, 1, 1); PG8_STAGE(PG8_SA(1, 0), a3, voffA);
            PG8_BAR; PG8_WAIT_L(0); PG8_MMA(1, 0, At, B0); PG8_BAR; PG8_SCHED;
            PG8_STAGE(PG8_SB(1, 1), b3 + hB, voffB);
            PG8_WAIT_V(6); PG8_BAR; PG8_MMA(1, 1, At, B1); PG8_BAR;
            }
        }
        if constexpr (SP2) { PG8_STAGE(PG8_SA(1, 1), nA + kstep + hA, voffA); PG8_SCHED; }
        if constexpr (ALIGN_EPI) { if (wr == 0) PG8_BAR; }
        if constexpr (!Epi::AFTER_DRAIN) { int lz = tid; asm volatile("" : "+v"(lz)); E(acc, cur, wr, wc, lz & 15, (lz >> 4) & 3); S.done(cur); }
        if (!has_next) break;
#pragma unroll
        for (int a = 0; a < 2; ++a)
#pragma unroll
            for (int b = 0; b < 2; ++b)
#pragma unroll
                for (int m = 0; m < 4; ++m)
#pragma unroll
                    for (int n = 0; n < 2; ++n) acc[a][b][m][n] = (f32x4){0.f, 0.f, 0.f, 0.f};
        rlx = (Epi::MIN_VM > 0) && E.relax(cur);
        cur = nxt; cA = nA; cB = nB; ++ui;
        if constexpr (ALIGN_EPI) { if (wr == 1) PG8_BAR; }
    }
    PG8_WAIT_V(0);
    if constexpr (!ALIGN_EPI) { if (wr == 0) PG8_BAR; }
    PG8_BAR;
    if constexpr (Epi::AFTER_DRAIN) { E.fused(acc, cur, wr, wc, fr, fq, lds, wid, lane); S.done(cur); }
#undef PG8_SA
#undef PG8_SB
#undef PG8_STAGE
#undef PG8_LDA
#undef PG8_LDB
#undef PG8_MMA
#undef PG8_WAIT_V
#undef PG8_WAIT_VX
#undef PG8_WAIT_L
#undef PG8_BAR
#undef PG8_SCHED
}
}
using pg8::Unit;
__device__ __forceinline__ u32x4 pack8(f32x4 a, f32x4 b) { u32x4 w; w.x = cvt_pk_bf16(a[0], a[1]); w.y = cvt_pk_bf16(a[2], a[3]); w.z = cvt_pk_bf16(b[0], b[1]); w.w = cvt_pk_bf16(b[2], b[3]); return w; }

struct EpiBf {
    static constexpr bool PERM = true, AFTER_DRAIN = false; static constexpr int MIN_VM = 16;
    __device__ __forceinline__ bool relax(const Unit& u) const { return true; }
    bf16_t* O; int ldc;
    __device__ __forceinline__ void operator()(const f32x4 (&acc)[2][2][4][2], const Unit& u, int wr, int wc, int fr, int fq) const {
        const int row0 = u.pm * 256 + wr * 64 + fr, col0 = u.pn * 256 + wc * 32 + 8 * fq;
#pragma unroll
        for (int ai = 0; ai < 2; ++ai)
#pragma unroll
            for (int m = 0; m < 4; ++m) { bf16_t* rowp = O + (size_t)(row0 + ai * 128 + m * 16) * ldc + col0;
#pragma unroll
                for (int bj = 0; bj < 2; ++bj) *(u32x4*)(rowp + bj * 128) = pack8(acc[ai][bj][m][0], acc[ai][bj][m][1]); }
    }
};

struct EpiBfRs {
    static constexpr bool PERM = true, AFTER_DRAIN = false; static constexpr int MIN_VM = 24;
    __device__ __forceinline__ bool relax(const Unit& u) const { return true; }
    bf16_t* O; int ldc; const float* rs;
    __device__ __forceinline__ void operator()(const f32x4 (&acc)[2][2][4][2], const Unit& u, int wr, int wc, int fr, int fq) const {
        const int row0 = u.pm * 256 + wr * 64 + fr, col0 = u.pn * 256 + wc * 32 + 8 * fq;
#pragma unroll
        for (int ai = 0; ai < 2; ++ai)
#pragma unroll
            for (int m = 0; m < 4; ++m) { const int row = row0 + ai * 128 + m * 16; const f32x4 sq = *(const f32x4*)(rs + (size_t)row * 4); const float r = 1.0f / sqrtf(((sq[0] + sq[1]) + (sq[2] + sq[3])) * (1.0f / 1024.0f) + EPS); bf16_t* rowp = O + (size_t)row * ldc + col0;
#pragma unroll
                for (int bj = 0; bj < 2; ++bj) *(u32x4*)(rowp + bj * 128) = pack8(acc[ai][bj][m][0] * r, acc[ai][bj][m][1] * r); }
    }
};

struct EpiZ {
    static constexpr bool PERM = true, AFTER_DRAIN = false; static constexpr int MIN_VM = 16;
    __device__ __forceinline__ bool relax(const Unit& u) const { return u.pn < 18; }
    bf16_t *zrx, *gz, *q, *kv; float* gates;
    __device__ __forceinline__ void operator()(const f32x4 (&acc)[2][2][4][2], const Unit& u, int wr, int wc, int fr, int fq) const {
        const int pn = u.pn, row0 = u.pm * 256 + wr * 64 + fr, cl = wc * 32 + 8 * fq;
        if (pn < 12) {
            bf16_t* base = zrx + (size_t)(pn >> 2) * (size_t)(32u << 20);     const int colt = (pn & 3) * 256; const bool act = (pn >= 4 && pn < 8);
#pragma unroll
            for (int ai = 0; ai < 2; ++ai)
#pragma unroll
                for (int m = 0; m < 4; ++m) { bf16_t* rowp = base + (size_t)(row0 + ai * 128 + m * 16) * 1024 + colt + cl;
#pragma unroll
                    for (int bj = 0; bj < 2; ++bj) { f32x4 v0 = acc[ai][bj][m][0], v1 = acc[ai][bj][m][1];
                        if (act) {
#pragma unroll
                            for (int e = 0; e < 4; ++e) { v0[e] = gelu_tanh(v0[e]); v1[e] = gelu_tanh(v1[e]); } }
                        *(u32x4*)(rowp + bj * 128) = pack8(v0, v1); } }
        } else if (pn < 18) {
            const int j = pn - 12, b = u.pm >> 4, tb = (u.pm & 15) * 256 + wr * 64 + fr;
#pragma unroll
            for (int ai = 0; ai < 2; ++ai)
#pragma unroll
                for (int m = 0; m < 4; ++m) { const int t = tb + ai * 128 + m * 16;
#pragma unroll
                    for (int bj = 0; bj < 2; ++bj) { bf16_t* dst = kv + ((size_t)((j * 8 + b) * 2 + bj) * S + t) * 128 + cl;
                        *(u32x4*)dst = pack8(acc[ai][bj][m][0], acc[ai][bj][m][1]); } }
        } else {
            if (wc == 0 && fq < 3) {
#pragma unroll
                for (int ai = 0; ai < 2; ++ai)
#pragma unroll
                    for (int m = 0; m < 4; ++m) { float* dst = gates + (size_t)(row0 + ai * 128 + m * 16) * 24 + 8 * fq;
                        f32x4 v0 = acc[ai][0][m][0], v1 = acc[ai][0][m][1];
#pragma unroll
                        for (int e = 0; e < 4; ++e) { v0[e] = sigmoidf_(v0[e]); v1[e] = sigmoidf_(v1[e]); }
                        *(f32x4*)dst = v0; *(f32x4*)(dst + 4) = v1; }
            }
        }
    }
};

static_assert(WS_R_GZ - WS_R_ZRX == 64 * MiB && WS_R_Q - WS_R_GZ == 64 * MiB, "EpiZ region spacing");
struct EpiMerge {
    static constexpr bool PERM = true, AFTER_DRAIN = false; static constexpr int MIN_VM = 24;
    __device__ __forceinline__ bool relax(const Unit& u) const { return true; }
    const bf16_t* ya; const bf16_t* yb; bf16_t* out;
    __device__ __forceinline__ void operator()(const f32x4 (&acc)[2][2][4][2], const Unit& u, int wr, int wc, int fr, int fq) const {
        const int row0 = u.pm * 256 + wr * 64 + fr, d0 = u.pn * 128 + wc * 32 + 8 * fq;
#pragma unroll
        for (int ai = 0; ai < 2; ++ai)
#pragma unroll
            for (int m = 0; m < 4; ++m) { const size_t off = (size_t)(row0 + ai * 128 + m * 16) * 1024 + d0;
                const u32x4 a = *(const u32x4*)(ya + off), b = *(const u32x4*)(yb + off);
                f32x4 o0, o1;
#pragma unroll
                for (int e = 0; e < 2; ++e) {
                    const f32x2 p0 = sigmoid2((f32x2){acc[ai][0][m][0][2 * e], acc[ai][0][m][0][2 * e + 1]}) * (f32x2){bf_lo(a[e]), bf_hi(a[e])} + sigmoid2((f32x2){acc[ai][1][m][0][2 * e], acc[ai][1][m][0][2 * e + 1]}) * (f32x2){bf_lo(b[e]), bf_hi(b[e])};
                    const f32x2 p1 = sigmoid2((f32x2){acc[ai][0][m][1][2 * e], acc[ai][0][m][1][2 * e + 1]}) * (f32x2){bf_lo(a[2 + e]), bf_hi(a[2 + e])} + sigmoid2((f32x2){acc[ai][1][m][1][2 * e], acc[ai][1][m][1][2 * e + 1]}) * (f32x2){bf_lo(b[2 + e]), bf_hi(b[2 + e])};
                    o0[2 * e] = p0.x; o0[2 * e + 1] = p0.y; o1[2 * e] = p1.x; o1[2 * e + 1] = p1.y; }
                *(u32x4*)(out + off) = pack8(o0, o1); }
    }
};

struct EpiResid {
    static constexpr bool PERM = true, AFTER_DRAIN = false; static constexpr int MIN_VM = 0;
    __device__ __forceinline__ bool relax(const Unit& u) const { return true; }
    const float* x; float* out;
    __device__ __forceinline__ void operator()(const f32x4 (&acc)[2][2][4][2], const Unit& u, int wr, int wc, int fr, int fq) const {
        const int row0 = u.pm * 256 + wr * 64 + fr, col0 = u.pn * 256 + wc * 32 + 8 * fq;
#pragma unroll
        for (int ai = 0; ai < 2; ++ai)
#pragma unroll
            for (int m = 0; m < 4; ++m)
#pragma unroll
                for (int bj = 0; bj < 2; ++bj) { const size_t off = (size_t)(row0 + ai * 128 + m * 16) * 1024 + col0 + bj * 128;
                    const f32x4 x0 = *(const f32x4*)(x + off), x1 = *(const f32x4*)(x + off + 4);
                    *(f32x4*)(out + off) = x0 + acc[ai][bj][m][0]; *(f32x4*)(out + off + 4) = x1 + acc[ai][bj][m][1]; }
    }
};

struct EpiPle {
    static constexpr bool PERM = true, AFTER_DRAIN = false; static constexpr int MIN_VM = 0;
    __device__ __forceinline__ bool relax(const Unit& u) const { return true; }
    float* h; const bf16_t* pp;
    __device__ __forceinline__ void operator()(const f32x4 (&acc)[2][2][4][2], const Unit& u, int wr, int wc, int fr, int fq) const {
        const int row0 = u.pm * 256 + wr * 64 + fr, col0 = u.pn * 256 + wc * 32 + 8 * fq;
#pragma unroll
        for (int ai = 0; ai < 2; ++ai)
#pragma unroll
            for (int m = 0; m < 4; ++m)
#pragma unroll
                for (int bj = 0; bj < 2; ++bj) { const size_t off = (size_t)(row0 + ai * 128 + m * 16) * 1024 + col0 + bj * 128;
                    f32x4 h0 = *(const f32x4*)(h + off), h1 = *(const f32x4*)(h + off + 4); const u32x4 pv = *(const u32x4*)(pp + off);
                    const f32x4 a0 = acc[ai][bj][m][0], a1 = acc[ai][bj][m][1];
                    h0[0] += sigmoidf_(a0[0]) * bf_lo(pv[0]); h0[1] += sigmoidf_(a0[1]) * bf_hi(pv[0]); h0[2] += sigmoidf_(a0[2]) * bf_lo(pv[1]); h0[3] += sigmoidf_(a0[3]) * bf_hi(pv[1]);
                    h1[0] += sigmoidf_(a1[0]) * bf_lo(pv[2]); h1[1] += sigmoidf_(a1[1]) * bf_hi(pv[2]); h1[2] += sigmoidf_(a1[2]) * bf_lo(pv[3]); h1[3] += sigmoidf_(a1[3]) * bf_hi(pv[3]);
                    *(f32x4*)(h + off) = h0; *(f32x4*)(h + off + 4) = h1; }
    }
};

#define PN_CNT(pm) (4096 + 64 * (pm))
constexpr int PN_PT_OFF = 131072, PN_SR_OFF = 135168 + 512;
struct EpiPleNorm {
    static constexpr bool PERM = true, AFTER_DRAIN = false; static constexpr int MIN_VM = 0;
    __device__ __forceinline__ bool relax(const Unit& u) const { return true; }
    const bf16_t* hb; float* out; const bf16_t* pp; const float* g; const float* rsrow; unsigned* slots; unsigned* ctl; LAS unsigned char* lds; unsigned want;
    __device__ __forceinline__ void operator()(const f32x4 (&acc_)[2][2][4][2], const Unit& u, int wr, int wc, int fr, int fq) const {
        f32x4 (&acc)[2][2][4][2] = const_cast<f32x4 (&)[2][2][4][2]>(acc_);
        const int wid = wr * 4 + wc, lane = fq * 16 + fr;
        const int row0 = u.pm * 256 + wr * 64 + fr, col0 = u.pn * 256 + wc * 32 + 8 * fq;
        LAS float* Pt = (LAS float*)(lds + PN_PT_OFF);
        LAS float* Sr = (LAS float*)(lds + PN_SR_OFF);
#pragma unroll
        for (int ai = 0; ai < 2; ++ai)
#pragma unroll
            for (int m = 0; m < 4; ++m) { float ss = 0.f; const float r3 = rsrow[row0 + ai * 128 + m * 16];
#pragma unroll
                for (int bj = 0; bj < 2; ++bj) { const size_t off = (size_t)(row0 + ai * 128 + m * 16) * 1024 + col0 + bj * 128;
                    const u32x4 hw = *(const u32x4*)(hb + off); f32x4 h0 = {bf_lo(hw[0]), bf_hi(hw[0]), bf_lo(hw[1]), bf_hi(hw[1])}, h1 = {bf_lo(hw[2]), bf_hi(hw[2]), bf_lo(hw[3]), bf_hi(hw[3])}; const u32x4 pv = *(const u32x4*)(pp + off);
                    const f32x4 a0 = acc[ai][bj][m][0] * r3, a1 = acc[ai][bj][m][1] * r3;
                    h0[0] += sigmoidf_(a0[0]) * bf_lo(pv[0]); h0[1] += sigmoidf_(a0[1]) * bf_hi(pv[0]); h0[2] += sigmoidf_(a0[2]) * bf_lo(pv[1]); h0[3] += sigmoidf_(a0[3]) * bf_hi(pv[1]);
                    h1[0] += sigmoidf_(a1[0]) * bf_lo(pv[2]); h1[1] += sigmoidf_(a1[1]) * bf_hi(pv[2]); h1[2] += sigmoidf_(a1[2]) * bf_lo(pv[3]); h1[3] += sigmoidf_(a1[3]) * bf_hi(pv[3]);
                    acc[ai][bj][m][0] = h0; acc[ai][bj][m][1] = h1;
                    ss += (h0[0] * h0[0] + h0[1] * h0[1]) + (h0[2] * h0[2] + h0[3] * h0[3]) + (h1[0] * h1[0] + h1[1] * h1[1]) + (h1[2] * h1[2] + h1[3] * h1[3]); }
                ss += __shfl_xor(ss, 16); ss += __shfl_xor(ss, 32);
                if (fq == 0) Pt[(ai * 128 + wr * 64 + m * 16 + fr) * 4 + wc] = ss; }
        asm volatile("s_waitcnt lgkmcnt(0)" ::: "memory"); __builtin_amdgcn_s_barrier(); asm volatile("" ::: "memory");
        const int row = wid * 32 + (lane & 31);
        if (lane < 32) { const f32x4 p = *(const LAS f32x4*)(Pt + row * 4);
            __hip_atomic_store(slots + (size_t)(u.pm * 256 + row) * 4 + u.pn, __float_as_uint((p[0] + p[1]) + (p[2] + p[3])), __ATOMIC_RELAXED, __HIP_MEMORY_SCOPE_AGENT); }
        asm volatile("s_waitcnt vmcnt(0)" ::: "memory");
        if (lane == 0) __hip_atomic_fetch_add(ctl + PN_CNT(u.pm), 1u, __ATOMIC_RELAXED, __HIP_MEMORY_SCOPE_AGENT);
        if (wid == 0) {
            unsigned sp = 0u;
            while ((unsigned)__builtin_amdgcn_readfirstlane(__hip_atomic_load(ctl + PN_CNT(u.pm), __ATOMIC_RELAXED, __HIP_MEMORY_SCOPE_AGENT)) < want) { __builtin_amdgcn_s_sleep(2); if (++sp > (1u << 20)) break; }
            __builtin_amdgcn_fence(__ATOMIC_ACQUIRE, "agent");
        }
        asm volatile("s_waitcnt vmcnt(0) lgkmcnt(0)" ::: "memory"); __builtin_amdgcn_s_barrier(); asm volatile("" ::: "memory");
        if (lane < 32) { const unsigned* sl = slots + (size_t)(u.pm * 256 + row) * 4; float s = 0.f;
#pragma unroll
            for (int t = 0; t < 4; ++t) s += __uint_as_float(__hip_atomic_load(sl + t, __ATOMIC_RELAXED, __HIP_MEMORY_SCOPE_AGENT));
            Sr[row] = 1.0f / sqrtf(s * (1.0f / 1024.0f) + EPS); }
        asm volatile("s_waitcnt lgkmcnt(0)" ::: "memory"); __builtin_amdgcn_s_barrier(); asm volatile("" ::: "memory");
        const f32x4 ga0 = *(const f32x4*)(g + col0), ga1 = *(const f32x4*)(g + col0 + 4), gb0 = *(const f32x4*)(g + col0 + 128), gb1 = *(const f32x4*)(g + col0 + 132);
#pragma unroll
        for (int ai = 0; ai < 2; ++ai)
#pragma unroll
            for (int m = 0; m < 4; ++m) { const float rs = Sr[ai * 128 + wr * 64 + m * 16 + fr];
#pragma unroll
                for (int bj = 0; bj < 2; ++bj) { const size_t off = (size_t)(row0 + ai * 128 + m * 16) * 1024 + col0 + bj * 128;
                    *(f32x4*)(out + off) = acc[ai][bj][m][0] * rs * (bj ? gb0 : ga0); *(f32x4*)(out + off + 4) = acc[ai][bj][m][1] * rs * (bj ? gb1 : ga1); } }
    }
};
struct EpiResidNorm {
    static constexpr bool PERM = true, AFTER_DRAIN = false; static constexpr int MIN_VM = 48;
    __device__ __forceinline__ bool relax(const Unit& u) const { return true; }
    const float* x; bf16_t* hb; unsigned* slots; unsigned* ctl; LAS unsigned char* lds; unsigned want;
    __device__ __forceinline__ void operator()(const f32x4 (&acc_)[2][2][4][2], const Unit& u, int wr, int wc, int fr, int fq) const {
        f32x4 (&acc)[2][2][4][2] = const_cast<f32x4 (&)[2][2][4][2]>(acc_);
        const int wid = wr * 4 + wc, lane = fq * 16 + fr;
        const int row0 = u.pm * 256 + wr * 64 + fr, col0 = u.pn * 256 + wc * 32 + 8 * fq;
        LAS float* Pt = (LAS float*)(lds + PN_PT_OFF);
        LAS float* Sr = (LAS float*)(lds + PN_SR_OFF);
#pragma unroll
        for (int ai = 0; ai < 2; ++ai)
#pragma unroll
            for (int m = 0; m < 4; ++m) { float ss = 0.f;
#pragma unroll
                for (int bj = 0; bj < 2; ++bj) { const size_t off = (size_t)(row0 + ai * 128 + m * 16) * 1024 + col0 + bj * 128;
                    const f32x4 h0 = *(const f32x4*)(x + off) + acc[ai][bj][m][0], h1 = *(const f32x4*)(x + off + 4) + acc[ai][bj][m][1];
                    *(u32x4*)(hb + off) = pack8(h0, h1);
                    acc[ai][bj][m][0] = h0; acc[ai][bj][m][1] = h1;
                    ss += (h0[0] * h0[0] + h0[1] * h0[1]) + (h0[2] * h0[2] + h0[3] * h0[3]) + (h1[0] * h1[0] + h1[1] * h1[1]) + (h1[2] * h1[2] + h1[3] * h1[3]); }
                ss += __shfl_xor(ss, 16); ss += __shfl_xor(ss, 32);
                if (fq == 0) Pt[(ai * 128 + wr * 64 + m * 16 + fr) * 4 + wc] = ss; }
        asm volatile("s_waitcnt lgkmcnt(0)" ::: "memory"); __builtin_amdgcn_s_barrier(); asm volatile("" ::: "memory");
        const int row = wid * 32 + (lane & 31);
        if (lane < 32) { const f32x4 p = *(const LAS f32x4*)(Pt + row * 4);
            __hip_atomic_store(slots + (size_t)(u.pm * 256 + row) * 4 + u.pn, __float_as_uint((p[0] + p[1]) + (p[2] + p[3])), __ATOMIC_RELAXED, __HIP_MEMORY_SCOPE_AGENT); }
        asm volatile("s_waitcnt lgkmcnt(0)" ::: "memory"); __builtin_amdgcn_s_barrier(); asm volatile("" ::: "memory");
    }
};
struct PanelOrder {
    int pm, pn, dpm, n;
    __device__ __forceinline__ bool next(int i, Unit& u) const { if (i >= n) return false; u.pm = pm + i * dpm; u.pn = pn; return true; }
    __device__ __forceinline__ void a_ready(const Unit&) const {}
    __device__ __forceinline__ void done(const Unit&) const {}
};

struct RangeOrder {
    int nN, first, count, nblk, me;
    __device__ __forceinline__ bool next(int i, Unit& u) const {
        if (me < 0) return false; const int L = i * nblk + me; if (L >= count) return false;
        const int idx = first + L; u.pm = idx / nN; u.pn = idx % nN; return true;
    }
    __device__ __forceinline__ void a_ready(const Unit&) const {}
    __device__ __forceinline__ void done(const Unit&) const {}
};
__device__ __forceinline__ void transpose_item(const float* __restrict__ W, int ldw, int nvalid, bf16_t* WT, int ldt, LAS float* scr, int kb, int nb, int lane, const float* kscale = nullptr) {
    const int k0 = 64 * kb, n0 = 32 * nb, nn = n0 + (lane & 31); const bool ok = nn < nvalid;
    float wv[32];
#pragma unroll
    for (int i = 0; i < 32; ++i) { const int kk = 2 * i + (lane >> 5); wv[i] = ok ? W[(size_t)(k0 + kk) * ldw + nn] : 0.f; }
    if (kscale) {
#pragma unroll
        for (int i = 0; i < 32; ++i) wv[i] *= kscale[k0 + 2 * i + (lane >> 5)]; }
#pragma unroll
    for (int i = 0; i < 32; ++i) { const int kk = 2 * i + (lane >> 5); scr[kk * 33 + (lane & 31)] = wv[i]; }
    LDS_WAIT(); asm volatile("" ::: "memory");
    const int c = lane & 7;
#pragma unroll
    for (int j = 0; j < 4; ++j) { const int n = (lane >> 3) + 8 * j; const LAS float* s = scr + (8 * c) * 33 + n;
        u32x4 o; o.x = cvt_pk_bf16(s[0 * 33], s[1 * 33]); o.y = cvt_pk_bf16(s[2 * 33], s[3 * 33]); o.z = cvt_pk_bf16(s[4 * 33], s[5 * 33]); o.w = cvt_pk_bf16(s[6 * 33], s[7 * 33]);
        *(u32x4*)(WT + (size_t)(n0 + n) * ldt + k0 + 8 * c) = o; }
    LDS_WAIT(); asm volatile("" ::: "memory");
}
__device__ __forceinline__ void rms_row(const float* xrow, const float* g, bf16_t* obf, float* of32, int lane) {
    f32x4 v[4]; float s = 0.f;
#pragma unroll
    for (int j = 0; j < 4; ++j) { v[j] = ((const f32x4*)xrow)[lane + 64 * j]; s += (v[j][0] * v[j][0] + v[j][1] * v[j][1]) + (v[j][2] * v[j][2] + v[j][3] * v[j][3]); }
    s = wave_sum(s);
    const float rs = 1.0f / sqrtf(s * (1.0f / 1024.0f) + EPS);
#pragma unroll
    for (int j = 0; j < 4; ++j) { const f32x4 gv = ((const f32x4*)g)[lane + 64 * j]; const f32x4 o = v[j] * rs * gv;
        if (obf) { u32x2 w; w.x = cvt_pk_bf16(o[0], o[1]); w.y = cvt_pk_bf16(o[2], o[3]); ((u32x2*)obf)[lane + 64 * j] = w; }
        else ((f32x4*)of32)[lane + 64 * j] = o; }
}

__device__ __forceinline__ void rms_rows2(const float* x0, const float* x1, const float* g, bf16_t* o0, bf16_t* o1, float* f0, float* f1, int lane) {
    f32x4 v[2][4]; float s0 = 0.f, s1 = 0.f;
#pragma unroll
    for (int j = 0; j < 4; ++j) { v[0][j] = ((const f32x4*)x0)[lane + 64 * j]; v[1][j] = ((const f32x4*)x1)[lane + 64 * j]; }
#pragma unroll
    for (int j = 0; j < 4; ++j) { s0 += (v[0][j][0] * v[0][j][0] + v[0][j][1] * v[0][j][1]) + (v[0][j][2] * v[0][j][2] + v[0][j][3] * v[0][j][3]);
                                  s1 += (v[1][j][0] * v[1][j][0] + v[1][j][1] * v[1][j][1]) + (v[1][j][2] * v[1][j][2] + v[1][j][3] * v[1][j][3]); }
#pragma unroll
    for (int o = 1; o < 64; o <<= 1) { s0 += __shfl_xor(s0, o); s1 += __shfl_xor(s1, o); }
    const float r0 = 1.0f / sqrtf(s0 * (1.0f / 1024.0f) + EPS), r1 = 1.0f / sqrtf(s1 * (1.0f / 1024.0f) + EPS);
#pragma unroll
    for (int j = 0; j < 4; ++j) { const f32x4 gv = ((const f32x4*)g)[lane + 64 * j]; const f32x4 a = v[0][j] * r0 * gv, b = v[1][j] * r1 * gv;
        if (o0) { u32x2 w; w.x = cvt_pk_bf16(a[0], a[1]); w.y = cvt_pk_bf16(a[2], a[3]); ((u32x2*)o0)[lane + 64 * j] = w; w.x = cvt_pk_bf16(b[0], b[1]); w.y = cvt_pk_bf16(b[2], b[3]); ((u32x2*)o1)[lane + 64 * j] = w; }
        else { ((f32x4*)f0)[lane + 64 * j] = a; ((f32x4*)f1)[lane + 64 * j] = b; } }
}
__device__ __forceinline__ void phase0(const Params& P, unsigned char* lds_raw) {
    const int tid = opaque_tid(), lane = tid & 63, wave = __builtin_amdgcn_readfirstlane(tid >> 6);
    const int gw = blockIdx.x * NWAVES + wave, NGW = gridDim.x * NWAVES;
    unsigned char* ws = P.ws;
    LAS float* scr = (LAS float*)((LAS unsigned char*)lds_raw + wave * 16384);
    if (blockIdx.x & 1) for (int m = 2 * gw; m < T; m += 2 * NGW) rms_rows2(P.in[I_X] + (size_t)m * D, P.in[I_X] + (size_t)(m + 1) * D, P.in[I_NORM_MIX], (bf16_t*)(ws + WS_R_XB) + (size_t)m * D, (bf16_t*)(ws + WS_R_XB) + (size_t)(m + 1) * D, nullptr, nullptr, lane);
    constexpr int N_WIN = 16 * 152, N_W1 = 1024, N_LRU = 128, N_ITEMS = N_WIN + N_W1 + N_LRU;
    for (int it = gw; it < N_ITEMS; it += NGW) {
        int r = it;
        if (r < N_WIN) { transpose_item(P.in[I_W_IN], DIN, 4632, (bf16_t*)(ws + WS_WIN_T), 1024, scr, r / 152, r % 152, lane); continue; } r -= N_WIN;
        if (r < N_W1) { const int which = r >> 9, rr = r & 511, half = rr >> 8, r2 = rr & 255;
            const float* src = (which ? P.in[I_W1_V] : P.in[I_W1_K]) + (size_t)half * 2048 * 256;
            bf16_t* dst = (bf16_t*)(ws + (which ? WS_W1V_T : WS_W1K_T)) + (size_t)half * 256 * 2048;
            transpose_item(src, 256, 256, dst, 2048, scr, r2 >> 3, r2 & 7, lane); continue; } r -= N_W1;
        { const int sub = r >> 3, rr = r & 7, n = sub >> 1, gate = sub & 1;
            const float* src = (gate ? P.in[I_LRU_WI] : P.in[I_LRU_WR]) + (size_t)n * 16384;
            transpose_item(src, 128, 128, (bf16_t*)(ws + WS_LRUW) + (size_t)(n * 256 + gate * 128) * 128, 128, scr, rr >> 2, rr & 3, lane); }
    }
    if (!(blockIdx.x & 1)) for (int m = 2 * gw; m < T; m += 2 * NGW) rms_rows2(P.in[I_X] + (size_t)m * D, P.in[I_X] + (size_t)(m + 1) * D, P.in[I_NORM_MIX], (bf16_t*)(ws + WS_R_XB) + (size_t)m * D, (bf16_t*)(ws + WS_R_XB) + (size_t)(m + 1) * D, nullptr, nullptr, lane);
    { const int gt = blockIdx.x * NTHREADS + tid, NGT = gridDim.x * NTHREADS;
      const int* pos = (const int*)P.in[I_POS]; float* ct = (float*)(ws + WS_COS); float* st = (float*)(ws + WS_SIN);
      for (int i = gt; i < T * 64; i += NGT) { const int t = i >> 6, f = i & 63;
          const float inv = exp2f(-(float)f * (13.287712379549449f / 64.0f));
          const float ang = (float)pos[t] * inv;
          const double rev = (double)ang * 0.15915494309189535; const float fr = (float)(rev - rint(rev));
          ct[i] = __builtin_amdgcn_cosf(fr); st[i] = __builtin_amdgcn_sinf(fr); } }
}
__device__ __forceinline__ void side_work(const Params& P, unsigned char* lds_raw, int sw, int nsw) {
    const int tid = opaque_tid(), lane = tid & 63, wave = __builtin_amdgcn_readfirstlane(tid >> 6);
    unsigned char* ws = P.ws;
    LAS float* scr = (LAS float*)((LAS unsigned char*)lds_raw + wave * 16384);
    constexpr int N_WM = 1024, N_SQ = 5 * 512, N_WP = 128, N_W2 = 32, N_ITEMS = N_WM + N_SQ + N_WP + N_W2;
    for (int it = sw; it < N_ITEMS; it += nsw) {
        int r = it;
        if (r < N_WM) { const int sub = r >> 6, rr = r & 63, pn = sub >> 1, half = sub & 1;
            transpose_item(P.in[I_W_IN] + 4632 + half * 1024 + 128 * pn, DIN, 128, (bf16_t*)(ws + WS_WM_T) + (size_t)(256 * pn + 128 * half) * 1024, 1024, scr, rr >> 2, rr & 3, lane); continue; } r -= N_WM;
        if (r < N_SQ) { const int which = r >> 9, rr = r & 511;
            const float* src = which == 0 ? P.in[I_W_A] : which == 1 ? P.in[I_W_B] : which == 2 ? P.in[I_W_OUT] : which == 3 ? P.in[I_PEER_WQ] : P.in[I_PLE_WG];
            const size_t dof = which == 0 ? WS_WA_T : which == 1 ? WS_WB_T : which == 2 ? WS_WOUT_T : which == 3 ? WS_WQ_T : WS_WG_T;
            transpose_item(src, 1024, 1024, (bf16_t*)(ws + dof), 1024, scr, rr >> 5, rr & 31, lane, which == 4 ? P.in[I_NORM_PLE] : which == 3 ? P.in[I_NORM_FFN] : nullptr); continue; } r -= N_SQ;
        if (r < N_WP) { transpose_item(P.in[I_PLE_WP], 1024, 1024, (bf16_t*)(ws + WS_WP_T), 256, scr, r >> 5, r & 31, lane); continue; } r -= N_WP;
        { const int j = r >> 4, rr = r & 15; transpose_item(P.in[j ? I_W2_V : I_W2_K], 128, 128, (bf16_t*)(ws + WS_W2T) + (size_t)j * 128 * 256, 256, scr, rr >> 2, rr & 3, lane); }
    }
    for (int it = sw; it < 128; it += nsw) { const int j = it >> 6, chunk = it & 63; const float* pe = P.in[j ? I_PE_V : I_PE_K]; const float* w1 = P.in[j ? I_W1_V : I_W1_K];
        f32x4 a = {0.f, 0.f, 0.f, 0.f};
#pragma unroll 16
        for (int f = chunk * 64; f < chunk * 64 + 64; ++f) { const float pv = pe[f]; const f32x4 w = ((const f32x4*)(w1 + (size_t)f * 256))[lane]; a += w * pv; }
        ((f32x4*)((float*)(ws + WS_C1P) + (size_t)(j * 64 + chunk) * 256))[lane] = a; }
}
constexpr int LRU_A = 0, LRU_XA = 65536, LRU_BW = 98304, LRU_WS = 114688, LRU_END = LRU_WS + 4096;
__device__ __forceinline__ void lru_unit(const Params& P, unsigned char* lds_raw, int b, int slab) {
    LAS unsigned char* lds = (LAS unsigned char*)lds_raw;
    const int tid = opaque_tid();
    const int lane = tid & 63, wave = __builtin_amdgcn_readfirstlane(tid >> 6);
    unsigned char* ws = P.ws;
    const int nblk = slab >> 2, sl = slab & 3;
    const bf16_t* zrx = (const bf16_t*)(ws + WS_R_ZRX) + (size_t)b * S * 1024 + 128 * nblk;
    bf16_t* gz = (bf16_t*)(ws + WS_R_GZ) + (size_t)b * S * 1024 + slab * 32;
    const int cg = tid & 15, tg = tid >> 4;
    { const bf16_t* lw = (const bf16_t*)(ws + WS_LRUW) + (size_t)nblk * 256 * 128;
#pragma unroll
      for (int e = 0; e < 2; ++e) { const int idx = tid + 512 * e, row = idx >> 4, ch = idx & 15, srow = (row >> 5) * 128 + sl * 32 + 2 * (row & 15) + ((row >> 4) & 1);
          *(LAS u32x4*)(lds + LRU_BW + row * 256 + ((ch ^ (row & 15)) << 4)) = *(const u32x4*)(lw + (size_t)srow * 128 + ch * 8); } }
    const int cc = lane & 15, grp = lane >> 4;
    float br_[2], bi_[2], sp8[2];
#pragma unroll
    for (int p = 0; p < 2; ++p) { const int c = slab * 32 + 2 * cc + p;
        br_[p] = P.in[I_LRU_BR][c]; bi_[p] = P.in[I_LRU_BI][c]; sp8[p] = 8.0f * log1pf(expf(-P.in[I_LRU_LAM][c])); }
    float hin[2] = {0.f, 0.f};
    float cw[4][8], cb[8];
    { const float* w = P.in[I_CONV_W] + 128 * nblk + 8 * cg; const float* bb = P.in[I_CONV_B] + 128 * nblk + 8 * cg;
#pragma unroll
      for (int k = 0; k < 4; ++k) { const f32x4 a = *(const f32x4*)(w + k * 1024), c = *(const f32x4*)(w + k * 1024 + 4);
#pragma unroll
          for (int e = 0; e < 4; ++e) { cw[k][e] = a[e]; cw[k][4 + e] = c[e]; } }
      const f32x4 a = *(const f32x4*)bb, c = *(const f32x4*)(bb + 4);
#pragma unroll
      for (int e = 0; e < 4; ++e) { cb[e] = a[e]; cb[4 + e] = c[e]; } }
    u32x4 rows[7]; unsigned gzp[4];
    const int tk0 = 16 * wave + 4 * grp;
#pragma unroll
    for (int i = 0; i < 7; ++i) { const int tr = 4 * tg - 3 + i; rows[i] = tr >= 0 ? *(const u32x4*)(zrx + (size_t)tr * 1024 + 8 * cg) : (u32x4){0u, 0u, 0u, 0u}; }
#pragma unroll
    for (int r = 0; r < 4; ++r) gzp[r] = *(const unsigned*)(gz + (size_t)(tk0 + r) * 1024 + 2 * cc);
#define LRU_CONV(CT) do { const int ct = (CT); LAS unsigned char* Ac = lds + LRU_A + (ct & 1) * 32768; LAS float* XAc = (LAS float*)(lds + LRU_XA + (ct & 1) * 16384); \
        { \
            float x[7][8]; \
_Pragma("unroll") \
            for (int i = 0; i < 7; ++i) \
_Pragma("unroll") \
                for (int e = 0; e < 4; ++e) { x[i][2 * e] = bf_lo(rows[i][e]); x[i][2 * e + 1] = bf_hi(rows[i][e]); } \
_Pragma("unroll") \
            for (int i = 0; i < 4; ++i) { float y[8]; \
_Pragma("unroll") \
                for (int e = 0; e < 8; ++e) y[e] = cb[e] + cw[0][e] * x[i][e] + cw[1][e] * x[i + 1][e] + cw[2][e] * x[i + 2][e] + cw[3][e] * x[i + 3][e]; \
                const int row = 4 * tg + i; \
                u32x4 w; w.x = cvt_pk_bf16(y[0], y[1]); w.y = cvt_pk_bf16(y[2], y[3]); w.z = cvt_pk_bf16(y[4], y[5]); w.w = cvt_pk_bf16(y[6], y[7]); \
                *(LAS u32x4*)(Ac + row * 256 + ((cg ^ (row & 15)) << 4)) = w; \
                if ((cg >> 2) == sl) { LAS float* xp = XAc + row * 32 + (cg & 3) * 8; \
                    *(LAS f32x4*)xp = (f32x4){y[0], y[1], y[2], y[3]}; *(LAS f32x4*)(xp + 4) = (f32x4){y[4], y[5], y[6], y[7]}; } } \
        } \
        if (ct + 1 < S / 128) {                                         \
_Pragma("unroll") \
            for (int i = 0; i < 7; ++i) { const int tr = ct * 128 + 128 + 4 * tg - 3 + i; rows[i] = *(const u32x4*)(zrx + (size_t)tr * 1024 + 8 * cg); } } \
    } while (0)
    LRU_CONV(0);
    __syncthreads();
    for (int tile = 0; tile < S / 128; ++tile) {
        const int t0 = tile * 128, buf = tile & 1;
        LAS unsigned char* At = lds + LRU_A + buf * 32768; LAS float* XAt = (LAS float*)(lds + LRU_XA + buf * 16384); LAS float* WSt = (LAS float*)(lds + LRU_WS + buf * 2048);
        float Ap[2][4], Hl[2][4], Ai[2], Hi[2];
        {
            f32x4 acc[4];
#pragma unroll
            for (int nt = 0; nt < 4; ++nt) acc[nt] = (f32x4){0.f, 0.f, 0.f, 0.f};
            const int arow = 16 * wave + cc;
#pragma unroll
            for (int ks = 0; ks < 4; ++ks) { const int chunk = 4 * ks + grp;
                const bf16x8 af = *(const LAS bf16x8*)(At + arow * 256 + ((chunk ^ (arow & 15)) << 4));
#pragma unroll
                for (int nt = 0; nt < 4; ++nt) { const int brow = 16 * nt + cc;
                    const bf16x8 bf = *(const LAS bf16x8*)(lds + LRU_BW + brow * 256 + ((chunk ^ (brow & 15)) << 4));
                    acc[nt] = __builtin_amdgcn_mfma_f32_16x16x32_bf16(af, bf, acc[nt], 0, 0, 0); } }
#pragma unroll
            for (int p = 0; p < 2; ++p) { float A = 1.f, H = 0.f;
#pragma unroll
                for (int r = 0; r < 4; ++r) {
                    const float rg = sigmoidf_(acc[p][r] + br_[p]), ig = sigmoidf_(acc[2 + p][r] + bi_[p]);
                    const float la = -rg * sp8[p], a = fast_exp2(la * LOG2E);
                    const float x2 = 2.f * la;
                    const float om = x2 > -0.02f ? -x2 * (1.f + x2 * (0.5f + x2 * (1.f / 6.f))) : 1.f - a * a;
                    const float u = __builtin_amdgcn_sqrtf(om) * ig * XAt[(tk0 + r) * 32 + 2 * cc + p];
                    H = a * H + u; A = A * a; Ap[p][r] = A; Hl[p][r] = H; }
                { const float As = __shfl_up(A, 16), Hs = __shfl_up(H, 16); if (grp >= 1) { H = A * Hs + H; A = A * As; } }
                { const float As = __shfl_up(A, 32), Hs = __shfl_up(H, 32); if (grp >= 2) { H = A * Hs + H; A = A * As; } }
                Ai[p] = A; Hi[p] = H; }
            if (grp == 3) *(LAS f32x4*)(WSt + (wave * 32 + 2 * cc) * 2) = (f32x4){Ai[0], Hi[0], Ai[1], Hi[1]};
        }
        if (tile + 1 < S / 128) LRU_CONV(tile + 1);
        __syncthreads();
        {
            float hw[2] = {hin[0], hin[1]}, hc[2] = {hin[0], hin[1]};
#pragma unroll
            for (int w = 0; w < 8; ++w) { const f32x4 t = *(const LAS f32x4*)(WSt + (w * 32 + 2 * cc) * 2);
                hc[0] = t[0] * hc[0] + t[1]; hc[1] = t[2] * hc[1] + t[3];
                if (w + 1 == wave) { hw[0] = hc[0]; hw[1] = hc[1]; } }
            hin[0] = hc[0]; hin[1] = hc[1];
            float hg[2];
#pragma unroll
            for (int p = 0; p < 2; ++p) { const float Ae = __shfl_up(Ai[p], 16), He = __shfl_up(Hi[p], 16); hg[p] = grp >= 1 ? Ae * hw[p] + He : hw[p]; }
            unsigned wv[4];
#pragma unroll
            for (int r = 0; r < 4; ++r) { const float h0 = Ap[0][r] * hg[0] + Hl[0][r], h1 = Ap[1][r] * hg[1] + Hl[1][r];
                wv[r] = cvt_pk_bf16(h0 * bf_lo(gzp[r]), h1 * bf_hi(gzp[r])); }
            if (tile + 1 < S / 128) {
#pragma unroll
                for (int r = 0; r < 4; ++r) gzp[r] = *(const unsigned*)(gz + (size_t)(t0 + 128 + tk0 + r) * 1024 + 2 * cc); }
            asm volatile("" ::: "memory");
#pragma unroll
            for (int r = 0; r < 4; ++r) { const unsigned w = wv[r];
                *(unsigned*)(gz + (size_t)(t0 + tk0 + r) * 1024 + 2 * cc) = w; }
        }
    }
#undef LRU_CONV
    __syncthreads();
}

__device__ __forceinline__ void rope8(const u32x4 a, const u32x4 b, const float* ct, const float* st, u32x4& oa, u32x4& ob) {
    const f32x4 c0 = *(const f32x4*)ct, c1 = *(const f32x4*)(ct + 4), s0 = *(const f32x4*)st, s1 = *(const f32x4*)(st + 4);
    float x1[8], x2[8], cc[8], ss[8];
#pragma unroll
    for (int e = 0; e < 4; ++e) { x1[2 * e] = bf_lo(a[e]); x1[2 * e + 1] = bf_hi(a[e]); x2[2 * e] = bf_lo(b[e]); x2[2 * e + 1] = bf_hi(b[e]); cc[e] = c0[e]; cc[4 + e] = c1[e]; ss[e] = s0[e]; ss[4 + e] = s1[e]; }
#pragma unroll
    for (int e = 0; e < 4; ++e) {
        oa[e] = cvt_pk_bf16(x1[2 * e] * cc[2 * e] - x2[2 * e] * ss[2 * e], x1[2 * e + 1] * cc[2 * e + 1] - x2[2 * e + 1] * ss[2 * e + 1]);
        ob[e] = cvt_pk_bf16(x2[2 * e] * cc[2 * e] + x1[2 * e] * ss[2 * e], x2[2 * e + 1] * cc[2 * e + 1] + x1[2 * e + 1] * ss[2 * e + 1]); }
}
__device__ __forceinline__ void rope_k_pass(const Params& P) {
    unsigned char* ws = P.ws; const float* ct = (const float*)(ws + WS_COS); const float* st = (const float*)(ws + WS_SIN);
    const int gt = blockIdx.x * NTHREADS + opaque_tid(), NGT = gridDim.x * NTHREADS;
    for (int i = gt; i < 2 * 16 * S * 8; i += NGT) { const int ch = i & 7, t = (i >> 3) & (S - 1), bg = (i >> 15) & 15, which = i >> 19;
        bf16_t* row = (bf16_t*)(ws + WS_R_KV) + ((size_t)(((which ? 4 : 2) * 8) * 2 + bg) * S + t) * 128;
        const int tt = (bg >> 1) * S + t;
        const u32x4 a = *(const u32x4*)(row + 8 * ch), b = *(const u32x4*)(row + 64 + 8 * ch); u32x4 oa, ob;
        rope8(a, b, ct + (size_t)tt * 64 + 8 * ch, st + (size_t)tt * 64 + 8 * ch, oa, ob);
        *(u32x4*)(row + 8 * ch) = oa; *(u32x4*)(row + 64 + 8 * ch) = ob; }
}
__device__ __forceinline__ void rope_q_pass(const Params& P) {
    unsigned char* ws = P.ws; const float* ct = (const float*)(ws + WS_COS); const float* st = (const float*)(ws + WS_SIN);
    const int gt = blockIdx.x * NTHREADS + opaque_tid(), NGT = gridDim.x * NTHREADS;
    const bf16_t* q = (const bf16_t*)(ws + WS_R_Q); bf16_t* qr = (bf16_t*)(ws + WS_R_ZRX);
    for (int i = gt; i < T * 8 * 8; i += NGT) { const int ch = i & 7, h = (i >> 3) & 7, t = i >> 6;
        const size_t off = (size_t)t * 1024 + h * 128 + 8 * ch;
        const u32x4 a = *(const u32x4*)(q + off), b = *(const u32x4*)(q + off + 64); u32x4 oa, ob;
        rope8(a, b, ct + (size_t)t * 64 + 8 * ch, st + (size_t)t * 64 + 8 * ch, oa, ob);
        *(u32x4*)(qr + off) = oa; *(u32x4*)(qr + off + 64) = ob; }
}

__device__ __forceinline__ void compress_mlp2(const Params& P, unsigned char* lds_raw) {
    LAS unsigned char* lds = (LAS unsigned char*)lds_raw;
    LAS float* c1s = (LAS float*)(lds + 16 * 528);
    unsigned char* ws = P.ws; const int tid = opaque_tid(), lane = tid & 63, wave = __builtin_amdgcn_readfirstlane(tid >> 6);
    for (int unit = blockIdx.x; unit < 512; unit += gridDim.x) {
        const int j = unit >> 8, bg = (unit >> 4) & 15, n0 = (unit & 15) * 16;
        const bf16_t* G = (const bf16_t*)(ws + WS_G12P) + ((size_t)j * 4096 + bg * 256) * 512;
        if (tid < 256) { float a = P.in[j ? I_B1_V : I_B1_K][tid]; const float* cp = (const float*)(ws + WS_C1P) + (size_t)j * 64 * 256 + tid;
#pragma unroll 16
            for (int c = 0; c < 64; ++c) a += cp[c * 256];
            c1s[tid] = a; }
        __syncthreads();
        { const int r = tid >> 5, h8 = (tid & 31) * 8, n = n0 + r;
          float s[8];
#pragma unroll
          for (int e = 0; e < 8; ++e) s[e] = c1s[h8 + e];
          if (n < NCMP) {
#pragma unroll
              for (int ks = 0; ks < 4; ++ks) { const bf16_t* Gk = G + (size_t)ks * 2 * 4096 * 512;
                  const u32x4 a = *(const u32x4*)(Gk + (size_t)n * 512 + h8), b = *(const u32x4*)(Gk + (size_t)(n + 1) * 512 + 256 + h8);
#pragma unroll
                  for (int e = 0; e < 4; ++e) { s[2 * e] += bf_lo(a[e]) + bf_lo(b[e]); s[2 * e + 1] += bf_hi(a[e]) + bf_hi(b[e]); } }
#pragma unroll
              for (int e = 0; e < 8; ++e) s[e] = gelu_tanh(s[e]);
          } else {
#pragma unroll
              for (int e = 0; e < 8; ++e) s[e] = 0.f; }
          u32x4 w; w.x = cvt_pk_bf16(s[0], s[1]); w.y = cvt_pk_bf16(s[2], s[3]); w.z = cvt_pk_bf16(s[4], s[5]); w.w = cvt_pk_bf16(s[6], s[7]);
          *(LAS u32x4*)(lds + r * 528 + h8 * 2) = w; }
        __syncthreads();
        { const bf16_t* w2t = (const bf16_t*)(ws + WS_W2T) + (size_t)j * 128 * 256 + (size_t)(16 * wave + (lane & 15)) * 256 + 8 * (lane >> 4);
          f32x4 acc = {0.f, 0.f, 0.f, 0.f};
#pragma unroll
          for (int ks = 0; ks < 8; ++ks) { const bf16x8 af = *(const LAS bf16x8*)(lds + (lane & 15) * 528 + (32 * ks + 8 * (lane >> 4)) * 2);
              const bf16x8 bfr = *(const bf16x8*)(w2t + 32 * ks);
              acc = __builtin_amdgcn_mfma_f32_16x16x32_bf16(af, bfr, acc, 0, 0, 0); }
          const int d = 16 * wave + (lane & 15); const float b2 = P.in[j ? I_B2_V : I_B2_K][d];
          bf16_t* kc = (bf16_t*)(ws + WS_KC) + ((size_t)(j * 16 + bg) * 256 + n0) * 128 + d;
#pragma unroll
          for (int r = 0; r < 4; ++r) { const int row = (lane >> 4) * 4 + r; const float v = (n0 + row < NCMP) ? acc[r] + b2 : 0.f; kc[(size_t)row * 128] = (bf16_t)(cvt_pk_bf16(v, 0.f) & 0xffffu); } }
        __syncthreads();
    }
}
namespace att {
constexpr int NW = 8, QBLK = 32, KVBLK = 64, DH = 128;
constexpr int SHM_V = KVBLK * DH * 2, SHM_K = KVBLK * DH * 2;
constexpr int OACC_OFF = 2 * SHM_V + 2 * SHM_K + NW * 64 * 4 + NW * 64 * 4;
constexpr int LDS_BYTES = OACC_OFF + 256 * 256;
constexpr float THR = 8.f;
constexpr float SCALE = ATT_SCALE;
constexpr int WINDOW_W = 512;
#define KSWZ(row, colB) ((row) * 256 + ((colB) ^ (((row) & 7) << 4)))
#define SBAR() __builtin_amdgcn_sched_barrier(0)
__device__ __forceinline__ int v_st(int k, int c) { const int kk = (k & ~0xC) | ((k & 4) << 1) | ((k & 8) >> 1); return ((kk >> 3) * 4 + (c >> 5)) * 512 + ((kk & 7) * 32 + (c & 31)) * 2; }
__device__ __forceinline__ int v_rd_base(int lane) { return ((lane & 3) << 3) | (((lane >> 2) & 3) << 6) | (((lane >> 4) & 1) << 5) | (((lane >> 5) & 1) << 8); }
constexpr int v_rd_off(int d0, int ks, int half) { return d0 * 512 + ks * 4096 + half * 2048; }
__device__ __forceinline__ int crow(int r, int hi) { return (r & 3) + 8 * (r >> 2) + 4 * hi; }
__device__ __forceinline__ unsigned cvtpk(float lo, float hi) { unsigned r; asm volatile("v_cvt_pk_bf16_f32 %0, %1, %2" : "=v"(r) : "v"(lo), "v"(hi)); return r; }
__device__ __forceinline__ bf16x8 load8(const bf16_t* p) { return *reinterpret_cast<const bf16x8*>(p); }
__device__ __forceinline__ void mask_tile(f32x16& p0, f32x16& p1, int dq, unsigned W) {
    const float NEG = -__builtin_inff();
#pragma unroll
    for (int r = 0; r < 16; ++r) {
        const int c = (r & 3) + 8 * (r >> 2);
        if ((unsigned)(dq - c) >= W) p0[r] = NEG;
        if ((unsigned)(dq - c - 32) >= W) p1[r] = NEG;
    }
}
__device__ __forceinline__ void mask_all(f32x16& p0, f32x16& p1, bool kill) {
    const float NEG = -__builtin_inff();
#pragma unroll
    for (int r = 0; r < 16; ++r) { p0[r] = kill ? NEG : p0[r]; p1[r] = kill ? NEG : p1[r]; }
}
__device__ __forceinline__ void partialSM(f32x16& p0, f32x16& p1, float& m_reg, float& mn, float& alpha, bool on = true) {
    float pmax = p0[0]; for (int r = 1; r < 16; ++r) pmax = fmaxf(pmax, p0[r]); for (int r = 0; r < 16; ++r) pmax = fmaxf(pmax, p1[r]);
    pmax = on ? pmax : -__builtin_inff();
    { auto rr = __builtin_amdgcn_permlane32_swap(__float_as_uint(pmax), __float_as_uint(pmax), false, false);
      pmax = fmaxf(__uint_as_float(rr[0]), __uint_as_float(rr[1])); }
    constexpr float C2 = 1.4426950408889634f * SCALE;
    if (__builtin_expect(__all((pmax - m_reg) * SCALE <= THR), 1)) { mn = m_reg; alpha = 1.f; }
    else { mn = fmaxf(m_reg, pmax); alpha = __builtin_amdgcn_exp2f((m_reg - mn) * C2); m_reg = mn; }
    const float mnL = on ? -mn * C2 : -__builtin_inff();
    for (int r = 0; r < 16; ++r) p0[r] = fmaf(p0[r], C2, mnL); for (int r = 0; r < 16; ++r) p1[r] = fmaf(p1[r], C2, mnL);
    for (int r = 0; r < 16; ++r) p0[r] = __builtin_amdgcn_exp2f(p0[r]);
}
__device__ __forceinline__ void finishSM(f32x16& p0, f32x16& p1, float alpha, float& l_reg, bf16x8& pa0, bf16x8& pa1, bf16x8& pa2, bf16x8& pa3) {
    for (int r = 0; r < 16; ++r) p1[r] = __builtin_amdgcn_exp2f(p1[r]);
    float ps = 0; for (int r = 0; r < 16; ++r) ps += p0[r]; for (int r = 0; r < 16; ++r) ps += p1[r];
    { auto rr = __builtin_amdgcn_permlane32_swap(__float_as_uint(ps), __float_as_uint(ps), false, false);
      ps = __uint_as_float(rr[0]) + __uint_as_float(rr[1]); }
    l_reg = l_reg * alpha + ps;
#define PK4(Pv, B_, OUT) do { unsigned a0 = cvtpk(Pv[B_+0], Pv[B_+1]), a1 = cvtpk(Pv[B_+2], Pv[B_+3]);                          \
        unsigned b0 = cvtpk(Pv[B_+4], Pv[B_+5]), b1 = cvtpk(Pv[B_+6], Pv[B_+7]);                                             \
        auto r0 = __builtin_amdgcn_permlane32_swap(a0, b0, false, false); auto r1 = __builtin_amdgcn_permlane32_swap(a1, b1, false, false); \
        u32x4 w = {r0[0], r1[0], r0[1], r1[1]}; OUT = *reinterpret_cast<bf16x8*>(&w); } while (0)
    PK4(p0, 0, pa0); PK4(p0, 8, pa1); PK4(p1, 0, pa2); PK4(p1, 8, pa3);
#undef PK4
}
__device__ __forceinline__ void qkt(f32x16& p0, f32x16& p1, const char* kbase, int r32, int hi, const bf16x8* qr) {
    p0 = f32x16{}; p1 = f32x16{};
    const char* kb[4];
#pragma unroll
    for (int dd = 0; dd < 4; ++dd) kb[dd] = kbase + KSWZ(r32, (dd * 16 + hi * 8) * 2);
#pragma unroll
    for (int d0 = 0; d0 < 8; ++d0) { const char* a = kb[d0 & 3] + (d0 >> 2) * 128;
        bf16x8 b0 = *reinterpret_cast<const bf16x8*>(a);
        bf16x8 b1 = *reinterpret_cast<const bf16x8*>(a + 32 * 256);
        p0 = __builtin_amdgcn_mfma_f32_32x32x16_bf16(b0, qr[d0], p0, 0, 0, 0);
        p1 = __builtin_amdgcn_mfma_f32_32x32x16_bf16(b1, qr[d0], p1, 0, 0, 0); }
}
template <int VB>
__device__ __forceinline__ void pv_tile(f32x16* o, int vb0, bf16x8 pa0, bf16x8 pa1, bf16x8 pa2, bf16x8 pa3) {
#define TRRD(dst, off) asm volatile("ds_read_b64_tr_b16 %0, %1 offset:%2" : "=&v"(dst) : "v"(vb0), "i"(off) : "memory")
#define PV_D0(d0) do { s16x4 l0, l1, l2, l3, h0, h1, h2, h3; constexpr int b_ = VB * SHM_V + v_rd_off(d0, 0, 0); \
        TRRD(l0, b_); TRRD(h0, b_ + 2048); TRRD(l1, b_ + 4096); TRRD(h1, b_ + 6144); TRRD(l2, b_ + 8192); TRRD(h2, b_ + 10240); TRRD(l3, b_ + 12288); TRRD(h3, b_ + 14336); \
        asm volatile("s_waitcnt lgkmcnt(0)" ::: "memory"); SBAR();   \
        o[d0] = __builtin_amdgcn_mfma_f32_32x32x16_bf16(pa0, (bf16x8){l0[0], l0[1], l0[2], l0[3], h0[0], h0[1], h0[2], h0[3]}, o[d0], 0, 0, 0);   \
        o[d0] = __builtin_amdgcn_mfma_f32_32x32x16_bf16(pa1, (bf16x8){l1[0], l1[1], l1[2], l1[3], h1[0], h1[1], h1[2], h1[3]}, o[d0], 0, 0, 0);   \
        o[d0] = __builtin_amdgcn_mfma_f32_32x32x16_bf16(pa2, (bf16x8){l2[0], l2[1], l2[2], l2[3], h2[0], h2[1], h2[2], h2[3]}, o[d0], 0, 0, 0);   \
        o[d0] = __builtin_amdgcn_mfma_f32_32x32x16_bf16(pa3, (bf16x8){l3[0], l3[1], l3[2], l3[3], h3[0], h3[1], h3[2], h3[3]}, o[d0], 0, 0, 0); } while (0)
    PV_D0(0); PV_D0(1); PV_D0(2); PV_D0(3);
#undef PV_D0
#undef TRRD
}

enum { MODE_CMP = 0, MODE_SEL = 1, MODE_WIN = 2 };
struct Blk {
    const bf16_t* Q;
    const bf16_t* K; const bf16_t* V;
    bf16_t* O;
    const float* gate;
    const unsigned* sel;
    int t0, mode, jlo, NT;
};
struct Seam { bf16x8 qr[8]; bf16x8 st_v0, st_v1, st_k0, st_k1; };

#define ROW(p, k0, rr) ((p) + (size_t)((k0) + (rr)) * DH + sc)
#define VMW() asm volatile("s_waitcnt vmcnt(0)" ::: "memory")
#define VMWN(n) asm volatile("s_waitcnt vmcnt(%0)" :: "i"(n) : "memory")
#define SLOAD_H(Kp, Vp, k0) do { S.st_v0 = load8(ROW(Vp, k0, sr)); S.st_v1 = load8(ROW(Vp, k0, 32 + sr)); S.st_k0 = load8(ROW(Kp, k0, sr)); S.st_k1 = load8(ROW(Kp, k0, 32 + sr)); } while (0)
#define SWRITE_HK(bf) do { *(bf16x8*)(K_lds + (bf) * SHM_K + kws) = S.st_k0; *(bf16x8*)(K_lds + (bf) * SHM_K + kws + 32 * 256) = S.st_k1; } while (0)
#define SWRITE_HV(bf) do { *(bf16x8*)(V_lds + (bf) * SHM_V + vst0) = S.st_v0; *(bf16x8*)(V_lds + (bf) * SHM_V + vst1) = S.st_v1; } while (0)
#define SWRITE_H(bf) do { SWRITE_HV(bf); SWRITE_HK(bf); } while (0)
#define QPTR(ref) ((ref).Q + (size_t)((wid & 1) * 32 + r32) * 1024 + (wid >> 1) * 128 + hi * 8)

__device__ __forceinline__ void attn_prime(const Blk& cur, char* lds, Seam& S) {
    const int tid = opaque_tid(), wid = __builtin_amdgcn_readfirstlane(tid >> 6), lane = tid & 63, r32 = lane & 31, hi = lane >> 5;
    const int sr = tid >> 4, sc = (tid & 15) * 8, kws = KSWZ(sr, sc * 2); char* K_lds = lds + 2 * SHM_V;
    const int kb0 = cur.jlo * KVBLK;
    const bf16_t* qp = QPTR(cur);
#pragma unroll
    for (int d0 = 0; d0 < 8; ++d0) S.qr[d0] = load8(qp + d0 * 16);
    SLOAD_H(cur.K, cur.V, kb0); VMW(); SWRITE_HK(0);
    __syncthreads();
}
__device__ __forceinline__ void attn_block(const Blk& cur, const Blk& nxt, char* lds, Seam& S) {
    const int tid = opaque_tid();
    const int wid = __builtin_amdgcn_readfirstlane(tid >> 6), lane = tid & 63, r32 = lane & 31, hi = lane >> 5;
    const int j_lo = cur.jlo, NT = cur.NT, mode = cur.mode;
    const int kbn = nxt.jlo * KVBLK;
    const int qlo = cur.t0 + (wid & 1) * QBLK, tok = qlo + r32;
    const int lim = (mode == MODE_CMP) ? ((tok - 31) >> 4) : tok;
    const int qm = lim - 4 * hi;
    char* V_lds = lds; char* K_lds = lds + 2 * SHM_V;
    float* wsm = (float*)(lds + 2 * SHM_V + 2 * SHM_K) + wid * 64; float* li_l = wsm, * al_l = wsm + 32;
    unsigned* sel_l = (unsigned*)(lds + 2 * SHM_V + 2 * SHM_K + NW * 64 * 4) + wid * 64;
    if (mode == MODE_SEL) { const unsigned* sp = cur.sel + (size_t)((wid & 1) * 32 + r32) * 4; sel_l[r32 * 2 + hi] = sp[hi]; }
    float m_reg = -1e30f, l_reg = 0; f32x16 o[4] = {};
    const int sr = tid >> 4, sc = (tid & 15) * 8, vst0 = v_st(sr, sc), vst1 = v_st(32 + sr, sc), kws = KSWZ(sr, sc * 2);
    const int vb0 = (int)(uintptr_t)V_lds + v_rd_base(lane);
    const bf16_t* Kh = cur.K; const bf16_t* Vh = cur.V;
#define RESC(a) do { if (__any((a) < 1.f)) { if (hi == 0) al_l[r32] = (a); asm volatile("s_waitcnt lgkmcnt(0)" ::: "memory");              \
                     for (int d_ = 0; d_ < 4; ++d_) for (int r = 0; r < 16; ++r) o[d_][r] *= al_l[crow(r, hi)]; } } while (0)
#define KBASE(t) ((j_lo + (t)) * KVBLK)
#define MASKT(P0_, P1_, t) do { const int kb_ = KBASE(t);                                                                                          \
        if (mode == MODE_CMP) { mask_tile(P0_, P1_, qm - kb_, 0x7fffffffu); }                                                                       \
        else if (mode == MODE_WIN) { if (kb_ + KVBLK - 1 > qlo || kb_ <= qlo + QBLK - 1 - WINDOW_W) mask_tile(P0_, P1_, qm - kb_, (unsigned)WINDOW_W); } \
        else { const int jb_ = j_lo + (t); const unsigned sw_ = sel_l[r32 * 2 + (jb_ >> 5)]; lane_on = (sw_ >> (jb_ & 31)) & 1u;                        \
               if (kb_ + KVBLK - 1 > qlo) mask_tile(P0_, P1_, qm - kb_, 0x7fffffffu); } } while (0)
    constexpr int NQL = 8;
#define SEAM_K0() do { VMWN(NQL); SWRITE_HK(0); SBAR(); } while (0)
    f32x16 pA0, pA1, pB0, pB1; float mnA, mnB, alA, alB; bf16x8 pa0, pa1, pa2, pa3; bool lane_on = true;
    SWRITE_HV(0); SBAR();
    if (NT > 1) SLOAD_H(Kh, Vh, KBASE(1));
    SBAR(); qkt(pA0, pA1, K_lds, r32, hi, S.qr);
    MASKT(pA0, pA1, 0); partialSM(pA0, pA1, m_reg, mnA, alA, lane_on);
    if (NT > 1) { VMW(); SWRITE_H(1); }
    __syncthreads();
#define HALF_STEP(PX0, PX1, mnX, alX, PY0, PY1, alY, t, KB, VB, SB) do {                                                      \
        SBAR(); qkt(PX0, PX1, K_lds + (KB) * SHM_K, r32, hi, S.qr);                                                            \
        finishSM(PY0, PY1, alY, l_reg, pa0, pa1, pa2, pa3); SBAR();                                                           \
        if ((t) + 1 < NT) { SLOAD_H(Kh, Vh, KBASE((t) + 1)); SBAR(); }                                                        \
        pv_tile<VB>(o, vb0, pa0, pa1, pa2, pa3); MASKT(PX0, PX1, (t)); partialSM(PX0, PX1, m_reg, mnX, alX, lane_on);                  \
        __syncthreads();                                                                                                      \
        if ((t) + 1 < NT) { VMW(); SWRITE_H(SB); }                                                                            \
        RESC(alX); __syncthreads(); } while (0)
    for (int t = 1; t + 1 < NT; t += 2) {
        HALF_STEP(pB0, pB1, mnB, alB, pA0, pA1, alA, t, 1, 0, 0);
        HALF_STEP(pA0, pA1, mnA, alA, pB0, pB1, alB, t + 1, 0, 1, 1);
    }
    const bool even = (NT & 1) == 0;
    if (even) { SBAR(); qkt(pB0, pB1, K_lds + SHM_K, r32, hi, S.qr); SBAR(); }
    SLOAD_H(nxt.K, nxt.V, kbn); SBAR();
    { const bf16_t* qp = QPTR(nxt);
#pragma unroll
      for (int d0 = 0; d0 < 8; ++d0) S.qr[d0] = load8(qp + d0 * 16); }
    SBAR();
    finishSM(pA0, pA1, alA, l_reg, pa0, pa1, pa2, pa3); SBAR();
    pv_tile<0>(o, vb0, pa0, pa1, pa2, pa3);
    if (even) { MASKT(pB0, pB1, NT - 1); partialSM(pB0, pB1, m_reg, mnB, alB, lane_on); __syncthreads(); RESC(alB);
        finishSM(pB0, pB1, alB, l_reg, pa0, pa1, pa2, pa3); SBAR(); pv_tile<1>(o, vb0, pa0, pa1, pa2, pa3); }
    SBAR(); SEAM_K0();
    if (hi == 0) { li_l[r32] = l_reg; al_l[r32] = cur.gate[(size_t)((wid & 1) * 32 + r32) * 24 + (wid >> 1) * 3]; }
    asm volatile("s_waitcnt lgkmcnt(0)" ::: "memory");
    float rli[16];
#pragma unroll
    for (int r = 0; r < 16; ++r) { const float lv = li_l[crow(r, hi)]; rli[r] = lv > 0.f ? al_l[crow(r, hi)] * __builtin_amdgcn_rcpf(lv) : 0.f; }
    char* oacc = lds + OACC_OFF + wid * 8192;
    if (mode != MODE_WIN) {
#pragma unroll
        for (int k = 0; k < 8; ++k) { const int d0 = k >> 1, rb = (k & 1) * 8; u32x4 w, old = {0u, 0u, 0u, 0u};
            if (mode != MODE_CMP) old = *(const u32x4*)(oacc + (k * 64 + lane) * 16);
#pragma unroll
            for (int e = 0; e < 4; ++e) { float va = o[d0][rb + 2 * e] * rli[rb + 2 * e], vb = o[d0][rb + 2 * e + 1] * rli[rb + 2 * e + 1];
                if (mode != MODE_CMP) { va += bf_lo(old[e]); vb += bf_hi(old[e]); }
                w[e] = cvtpk(va, vb); }
            *(u32x4*)(oacc + (k * 64 + lane) * 16) = w; }
        __syncthreads();
    } else {
#pragma unroll
        for (int k = 0; k < 8; ++k) { const int d0 = k >> 1, rb = (k & 1) * 8; const u32x4 old = *(const u32x4*)(oacc + (k * 64 + lane) * 16);
#pragma unroll
            for (int e = 0; e < 4; ++e) { o[d0][rb + 2 * e] = o[d0][rb + 2 * e] * rli[rb + 2 * e] + bf_lo(old[e]); o[d0][rb + 2 * e + 1] = o[d0][rb + 2 * e + 1] * rli[rb + 2 * e + 1] + bf_hi(old[e]); } }
        asm volatile("s_waitcnt lgkmcnt(0)" ::: "memory");
#pragma unroll
        for (int r = 0; r < 16; ++r) { const int orow = crow(r, hi);
#pragma unroll
            for (int d0 = 0; d0 < 4; ++d0) { const float v = o[d0][r]; const float vn = __uint_as_float(__builtin_amdgcn_mov_dpp(__float_as_uint(v), 0xB1, 0xf, 0xf, true));
                if ((r32 & 1) == 0) *(unsigned*)(oacc + orow * 256 + (d0 * 32 + r32) * 2) = cvtpk(v, vn); } }
        __syncthreads();
#pragma unroll
        for (int i = 0; i < 8; ++i) { const int idx = tid + 512 * i, rho = idx >> 4, c16 = idx & 15, wv = rho >> 5;
            const u32x4 val = *(const u32x4*)(lds + OACC_OFF + rho * 256 + c16 * 16);
            *(u32x4*)(cur.O + (size_t)((wv & 1) * 32 + (rho & 31)) * 1024 + (wv >> 1) * 128 + c16 * 8) = val; }
    }
#undef RESC
#undef KBASE
#undef MASKT
#undef SEAM_K0
#undef HALF_STEP
}

__device__ __forceinline__ void imp_unit(const Params& P, char* lds, int bg, int tq) {
    const int tid = opaque_tid();
    const int wid = __builtin_amdgcn_readfirstlane(tid >> 6), lane = tid & 63, r32 = lane & 31, hi = lane >> 5;
    unsigned char* ws = P.ws; const int b = bg >> 1, g = bg & 1;
    const bf16_t* kc = (const bf16_t*)(ws + WS_KC) + (size_t)bg * 256 * 128;
    { const int sr = tid >> 4, sc = (tid & 15) * 8;
#pragma unroll
      for (int p = 0; p < 8; ++p) { const int row = sr + 32 * p; *(bf16x8*)(lds + (row >> 6) * SHM_K + KSWZ(row & 63, sc * 2)) = load8(kc + (size_t)row * 128 + sc); } }
    __syncthreads();
    const int tok = tq * 256 + wid * 32 + r32, lim4 = ((tok - 31) >> 4) - 4 * hi;
    const int limmax = tq * 16 + wid * 2, limmin = (tq * 256 + wid * 32 - 31) >> 4, ntw = (limmax >> 6) + 1;
    const bf16_t* qrow = (const bf16_t*)(ws + WS_R_Q) + (size_t)(b * S + tok) * 1024 + g * 512 + hi * 8;
    constexpr float C2 = 1.4426950408889634f * SCALE;
    float accG[32], accL[32];
#pragma unroll
    for (int i = 0; i < 32; ++i) { accG[i] = 0.f; accL[i] = 0.f; }
    for (int h = 0; h < 4; ++h) {
        bf16x8 qr[8];
#pragma unroll
        for (int d0 = 0; d0 < 8; ++d0) qr[d0] = load8(qrow + h * 128 + d0 * 16);
        float m = -1e30f;
        int lim4a = lim4; asm volatile("" : "+v"(lim4a));
#pragma unroll
        for (int t = 0; t < 4; ++t) if (t < ntw) { f32x16 p0, p1; qkt(p0, p1, lds + t * SHM_K, r32, hi, qr); if (64 * t + 63 > limmin) mask_tile(p0, p1, lim4a - 64 * t, 0x7fffffffu);
            float pmax = p0[0];
#pragma unroll
            for (int r = 1; r < 16; ++r) pmax = fmaxf(pmax, p0[r]);
#pragma unroll
            for (int r = 0; r < 16; ++r) pmax = fmaxf(pmax, p1[r]);
            m = fmaxf(m, pmax); SBAR(); }
        { auto rr = __builtin_amdgcn_permlane32_swap(__float_as_uint(m), __float_as_uint(m), false, false); m = fmaxf(__uint_as_float(rr[0]), __uint_as_float(rr[1])); }
        int lim4b = lim4; asm volatile("" : "+v"(lim4b));
        float tG[32], tL[32];
#pragma unroll
        for (int t = 0; t < 4; ++t) if (t < ntw) { f32x16 p0, p1; qkt(p0, p1, lds + t * SHM_K, r32, hi, qr); if (64 * t + 63 > limmin) mask_tile(p0, p1, lim4b - 64 * t, 0x7fffffffu);
#pragma unroll
            for (int q = 0; q < 4; ++q) {
                const float e0 = __builtin_amdgcn_exp2f((p0[4 * q] - m) * C2), e1 = __builtin_amdgcn_exp2f((p0[4 * q + 1] - m) * C2), e2 = __builtin_amdgcn_exp2f((p0[4 * q + 2] - m) * C2), e3 = __builtin_amdgcn_exp2f((p0[4 * q + 3] - m) * C2);
                tG[t * 8 + q] = (e0 + e1) + (e2 + e3); tL[t * 8 + q] = e3;
                const float f0 = __builtin_amdgcn_exp2f((p1[4 * q] - m) * C2), f1 = __builtin_amdgcn_exp2f((p1[4 * q + 1] - m) * C2), f2 = __builtin_amdgcn_exp2f((p1[4 * q + 2] - m) * C2), f3 = __builtin_amdgcn_exp2f((p1[4 * q + 3] - m) * C2);
                tG[t * 8 + 4 + q] = (f0 + f1) + (f2 + f3); tL[t * 8 + 4 + q] = f3; } SBAR(); }
            else {
#pragma unroll
                for (int q = 0; q < 8; ++q) { tG[t * 8 + q] = 0.f; tL[t * 8 + q] = 0.f; } }
        float l = 0.f;
#pragma unroll
        for (int i = 0; i < 32; ++i) l += tG[i];
        { auto rr = __builtin_amdgcn_permlane32_swap(__float_as_uint(l), __float_as_uint(l), false, false); l = __uint_as_float(rr[0]) + __uint_as_float(rr[1]); }
        const float inv = l > 0.f ? 1.0f / l : 0.f;
#pragma unroll
        for (int i = 0; i < 32; ++i) { accG[i] += tG[i] * inv; accL[i] += tL[i] * inv; }
    }
    unsigned r16[16];
#pragma unroll
    for (int s = 0; s < 16; ++s) r16[s] = 0u;
#define TOPK_INS(X) do { unsigned x_ = (X); _Pragma("unroll") for (int s = 0; s < 16; ++s) { const unsigned hi_ = r16[s] > x_ ? r16[s] : x_; x_ = r16[s] > x_ ? x_ : r16[s]; r16[s] = hi_; } } while (0)
    int cur = tok >> 6; asm volatile("" : "+v"(cur));
    float plprev = 0.f;
#pragma unroll
    for (int i = 0; i < 32; ++i) {
        auto rr = __builtin_amdgcn_permlane32_swap(__float_as_uint(accL[i]), __float_as_uint(accL[i]), false, false);
        const float pl = __uint_as_float(hi ? rr[0] : rr[1]);
        const float imp = accG[i] + (hi ? pl : plprev); plprev = pl;
        const int j = 2 * i + hi; const bool forced = (j == 0) | (j == cur) | (j == cur - 1), valid = j <= cur;
        const unsigned key = forced ? (0x7f800000u | (unsigned)(63 - j)) : valid ? ((__float_as_uint(imp) & ~63u) | (unsigned)(63 - j)) : 0u;
        TOPK_INS(key);
        if ((i & 3) == 3) SBAR();
    }
    unsigned mine[16];
#pragma unroll
    for (int s = 0; s < 16; ++s) mine[s] = r16[s];
#pragma unroll
    for (int s = 0; s < 16; ++s) { auto rr = __builtin_amdgcn_permlane32_swap(mine[s], mine[s], false, false); TOPK_INS(hi ? rr[0] : rr[1]); }
#undef TOPK_INS
    unsigned m0 = 0u, m1 = 0u;
#pragma unroll
    for (int s = 0; s < 16; ++s) if (r16[s]) { const unsigned j = 63u - (r16[s] & 63u); if (j < 32u) m0 |= 1u << j; else m1 |= 1u << (j - 32u); }
    if (hi == 0) { unsigned* sp = (unsigned*)(ws + WS_SEL) + ((size_t)(b * S + tok) * 2 + g) * 2; sp[0] = m0; sp[1] = m1; }
    __syncthreads();
}
#undef ROW
#undef VMW
#undef VMWN
#undef SLOAD_H
#undef SWRITE_HK
#undef SWRITE_HV
#undef SWRITE_H
#undef QPTR
}
#define XB_TMO      128
#define XB_XCNT(j)  (256  + 64 * (j))
#define XB_XSUB(j)  (1280 + 64 * (j))
#define XB_XGEN(j)  (2304 + 64 * (j))
#define XB_TOP      3328
#define XB_TOPGEN   3392
#define XCD_BAR_WORDS 3456
#define XB_SPIN_CAP (1u << 18)

__device__ __forceinline__ unsigned xb_ld(unsigned* p)              { return __hip_atomic_load(p, __ATOMIC_RELAXED, __HIP_MEMORY_SCOPE_AGENT); }
__device__ __forceinline__ unsigned xb_add(unsigned* p, unsigned v) { return __hip_atomic_fetch_add(p, v, __ATOMIC_RELAXED, __HIP_MEMORY_SCOPE_AGENT); }
__device__ __forceinline__ unsigned xb_xcc_id() { return (unsigned)__builtin_amdgcn_s_getreg((3 << 11) | 20) & 0xFu; }
#define XB_SPIN(cond, bar) do { unsigned _sp = 0; while (cond) { __builtin_amdgcn_s_sleep(1); \
    if ((++_sp & 255u) == 0u) { if (xb_ld(&(bar)[XB_TMO])) break; if (_sp > XB_SPIN_CAP) { atomicAdd(&(bar)[XB_TMO], 1u); break; } } } } while (0)

struct XcdBarrier {
    unsigned* bar; unsigned x;
    volatile LAS unsigned* st;
};

__device__ __forceinline__ XcdBarrier xcd_barrier_post(unsigned* bar, volatile LAS unsigned* st) {
    XcdBarrier b; b.bar = bar; b.x = xb_xcc_id(); b.st = st;
    if (opaque_tid() == 0) (void)xb_add(&bar[XB_XCNT(b.x)], 1u);
    return b;
}
__device__ __forceinline__ void xcd_barrier_complete(unsigned* bar, unsigned x, unsigned& nloc, unsigned& nx) {
    const unsigned G = gridDim.x * gridDim.y * gridDim.z;
    unsigned sum, cnt, mine, sp = 0u;
    for (;;) {
        sum = 0u; cnt = 0u; mine = 0u;
#pragma unroll
        for (unsigned j = 0; j < 16; ++j) { const unsigned c = xb_ld(&bar[XB_XCNT(j)]); sum += c; cnt += (c > 0u) ? 1u : 0u; mine = (j == x) ? c : mine; }
        if (sum == G) break;
        __builtin_amdgcn_s_sleep(1);
        if ((++sp & 255u) == 0u) { if (xb_ld(&bar[XB_TMO])) break; if (sp > XB_SPIN_CAP) { atomicAdd(&bar[XB_TMO], 1u); break; } }
    }
    nloc = mine > 0u ? mine : 1u; nx = cnt > 0u ? cnt : 1u;
}

__device__ __forceinline__ void xcd_barrier(const XcdBarrier& b) {
    asm volatile("s_waitcnt vmcnt(0)" ::: "memory");
    __syncthreads();
    if (opaque_tid() == 0) {
        unsigned* bar = b.bar;
        __builtin_amdgcn_s_waitcnt(0);
        unsigned nloc = b.st[0], nx = b.st[1];
        if (nloc == 0u) { xcd_barrier_complete(bar, b.x, nloc, nx); b.st[0] = nloc; b.st[1] = nx; }
        const unsigned old = xb_add(&bar[XB_XSUB(b.x)], 1u);
        const unsigned gen = old / nloc;
        if (old + 1u == (gen + 1u) * nloc) {
            __builtin_amdgcn_fence(__ATOMIC_RELEASE, "agent");
            asm volatile("s_waitcnt vmcnt(0)" ::: "memory");
            const unsigned og = xb_add(&bar[XB_TOP], 1u);
            const unsigned tg = og / nx;
            if (og + 1u == (tg + 1u) * nx) xb_add(&bar[XB_TOPGEN], 1u);
            else XB_SPIN(xb_ld(&bar[XB_TOPGEN]) == tg, bar);
            __builtin_amdgcn_fence(__ATOMIC_ACQUIRE, "agent");
            xb_add(&bar[XB_XGEN(b.x)], 1u);
            asm volatile("s_waitcnt vmcnt(0)" ::: "memory");
        } else {
            XB_SPIN(xb_ld(&bar[XB_XGEN(b.x)]) == gen, bar);
            __builtin_amdgcn_fence(__ATOMIC_ACQUIRE, "agent");
            asm volatile("s_waitcnt vmcnt(0)" ::: "memory");
        }
    }
    __syncthreads();
}
namespace peer {
__device__ __forceinline__ unsigned sortable(float f) { const unsigned u = __float_as_uint(f); return u ^ ((unsigned)((int)u >> 31) | 0x80000000u); }
__device__ __forceinline__ float unsortable(unsigned k) { const unsigned u = (k & 0x80000000u) ? (k ^ 0x80000000u) : ~k; return __uint_as_float(u); }
__device__ __forceinline__ void sort16_desc(unsigned (&v)[16]) {
#pragma unroll
    for (int k = 2; k <= 16; k <<= 1)
#pragma unroll
        for (int j = k >> 1; j > 0; j >>= 1)
#pragma unroll
            for (int i = 0; i < 16; ++i) { const int l = i ^ j; if (l > i) { const bool desc = (i & k) == 0; const unsigned a = v[i], b = v[l], mx = a > b ? a : b, mn = a > b ? b : a; v[i] = desc ? mx : mn; v[l] = desc ? mn : mx; } }
}
__device__ __forceinline__ void merge16_desc(unsigned (&a)[16], const unsigned (&b)[16]) {
#pragma unroll
    for (int i = 0; i < 16; ++i) a[i] = a[i] > b[15 - i] ? a[i] : b[15 - i];
#pragma unroll
    for (int j = 8; j > 0; j >>= 1)
#pragma unroll
        for (int i = 0; i < 16; ++i) { const int l = i ^ j; if (l > i) { const unsigned x = a[i], y = a[l]; a[i] = x > y ? x : y; a[l] = x > y ? y : x; } }
}
#define INS16(R, X) do { unsigned x_ = (X); _Pragma("unroll") for (int s_ = 0; s_ < 16; ++s_) { const unsigned h_ = R[s_] > x_ ? R[s_] : x_; x_ = R[s_] > x_ ? x_ : R[s_]; R[s_] = h_; } } while (0)

__device__ __forceinline__ void stage_keys(const Params& P, LAS unsigned char* lds) {
    const int tid = opaque_tid();
    { const float* keys = P.in[I_PEER_KEYS];
      for (int i = tid; i < 2 * 128 * 8; i += NTHREADS) { const int ch = i & 7, row = i >> 3;
          const f32x4 a = *(const f32x4*)(keys + (size_t)row * 64 + ch * 8), b = *(const f32x4*)(keys + (size_t)row * 64 + ch * 8 + 4);
          *(LAS u32x4*)(lds + row * 128 + ((ch ^ (row & 7)) << 4)) = pack8(a, b); } }
    __syncthreads();
}
__device__ __forceinline__ void topk_item(const bf16_t* qp, LAS unsigned char* lds, int item, LAS int* e_out, LAS float* g_out) {
        const int lane2 = opaque_tid() & 63, r32 = lane2 & 31, hi = lane2 >> 5;
        const int tok = item * 4 + (r32 >> 3), head = r32 & 7;
        const bf16_t* qrow = qp + (size_t)tok * 1024 + head * 128 + hi * 8;
        unsigned L[2][16];
        int kb4[4];
#pragma unroll
        for (int ks = 0; ks < 4; ++ks) kb4[ks] = r32 * 128 + (((ks * 2 + hi) ^ (r32 & 7)) << 4);
#pragma unroll
        for (int c = 0; c < 2; ++c) {
            bf16x8 qf[4];
#pragma unroll
            for (int ks = 0; ks < 4; ++ks) qf[ks] = *(const bf16x8*)(qrow + c * 64 + ks * 16);
            unsigned r16[16];
#pragma unroll
            for (int kt = 0; kt < 4; ++kt) {
                f32x16 p = {};
#pragma unroll
                for (int ks = 0; ks < 4; ++ks) { const bf16x8 kf = *(const LAS bf16x8*)(lds + kb4[ks] + (c * 128 + kt * 32) * 128);
                    p = __builtin_amdgcn_mfma_f32_32x32x16_bf16(kf, qf[ks], p, 0, 0, 0); }
                unsigned g16[16];
#pragma unroll
                for (int r = 0; r < 16; ++r) { const int n = kt * 32 + (r & 3) + 8 * (r >> 2) + 4 * hi; g16[r] = (sortable(p[r]) & ~127u) | (unsigned)(127 - n); }
                sort16_desc(g16);
                if (kt == 0) {
#pragma unroll
                    for (int s = 0; s < 16; ++s) r16[s] = g16[s]; }
                else merge16_desc(r16, g16);
                __builtin_amdgcn_sched_barrier(0);
            }
            { unsigned pr[16];
#pragma unroll
              for (int s = 0; s < 16; ++s) { auto rr = __builtin_amdgcn_permlane32_swap(r16[s], r16[s], false, false); pr[s] = hi ? rr[0] : rr[1]; }
              merge16_desc(r16, pr); }
#pragma unroll
            for (int s = 0; s < 16; ++s) L[c][s] = r16[s];
        }
        unsigned key[16], pay[16];
#pragma unroll
        for (int s = 0; s < 16; ++s) { key[s] = 0u; pay[s] = 0u; }
#pragma unroll
        for (int i = 0; i < 16; ++i) {
            const float v1 = unsortable(L[0][i] & ~127u); const unsigned i1 = 127u - (L[0][i] & 127u);
#pragma unroll
            for (int j = 0; j < 16; ++j) {
                if ((i + 1) * (j + 1) <= 16) {
                    const float v2 = unsortable(L[1][j] & ~127u); const unsigned i2 = 127u - (L[1][j] & 127u);
                    unsigned xk = (sortable(v1 + v2) & ~255u) | (unsigned)(255 - (i * 16 + j)), xp = i1 * 128u + i2;
#pragma unroll
                    for (int s = (i + 1) * (j + 1) - 1; s < 16; ++s) { const bool gt = xk > key[s];
                        const unsigned nk = gt ? xk : key[s], np = gt ? xp : pay[s]; xk = gt ? key[s] : xk; xp = gt ? pay[s] : xp; key[s] = nk; pay[s] = np; }
                }
            }
            __builtin_amdgcn_sched_barrier(0);
        }
        float bv[16], den = 0.f; const float bm = unsortable(key[0] & ~255u);
#pragma unroll
        for (int s = 0; s < 16; ++s) { bv[s] = __builtin_amdgcn_exp2f((unsortable(key[s] & ~255u) - bm) * LOG2E); den += bv[s]; }
        const float rden = 1.0f / den;
        if (hi == 0) { LAS int* ep = e_out + (r32 >> 3) * 128 + head * 16; LAS float* gp = g_out + (r32 >> 3) * 128 + head * 16;
#pragma unroll
            for (int s4 = 0; s4 < 4; ++s4) { *(LAS u32x4*)(ep + 4 * s4) = (u32x4){pay[4 * s4], pay[4 * s4 + 1], pay[4 * s4 + 2], pay[4 * s4 + 3]};
                *(LAS f32x4*)(gp + 4 * s4) = (f32x4){bv[4 * s4] * rden, bv[4 * s4 + 1] * rden, bv[4 * s4 + 2] * rden, bv[4 * s4 + 3] * rden}; } }
}
__device__ __forceinline__ float dpp_sum16(float v) {
    v += __uint_as_float(__builtin_amdgcn_mov_dpp(__float_as_uint(v), 0xB1, 0xf, 0xf, true));
    v += __uint_as_float(__builtin_amdgcn_mov_dpp(__float_as_uint(v), 0x4E, 0xf, 0xf, true));
    v += __uint_as_float(__builtin_amdgcn_mov_dpp(__float_as_uint(v), 0x141, 0xf, 0xf, true));
    v += __uint_as_float(__builtin_amdgcn_mov_dpp(__float_as_uint(v), 0x140, 0xf, 0xf, true));
    return v;
}
__device__ __forceinline__ float dpp_max16(float v) {
    v = fmaxf(v, __uint_as_float(__builtin_amdgcn_mov_dpp(__float_as_uint(v), 0xB1, 0xf, 0xf, true)));
    v = fmaxf(v, __uint_as_float(__builtin_amdgcn_mov_dpp(__float_as_uint(v), 0x4E, 0xf, 0xf, true)));
    v = fmaxf(v, __uint_as_float(__builtin_amdgcn_mov_dpp(__float_as_uint(v), 0x141, 0xf, 0xf, true)));
    v = fmaxf(v, __uint_as_float(__builtin_amdgcn_mov_dpp(__float_as_uint(v), 0x140, 0xf, 0xf, true)));
    return v;
}
__device__ __forceinline__ void peer_phase(const Params& P, unsigned char* lds_raw, int it0, int it1) {
    const int tid = opaque_tid(), wave = __builtin_amdgcn_readfirstlane(tid >> 6);
    const int gw = blockIdx.x * NWAVES + wave, NGW = gridDim.x * NWAVES;
    unsigned char* ws = P.ws;
    LAS unsigned char* lds = (LAS unsigned char*)lds_raw;
    stage_keys(P, lds);
    LAS int* e_w = (LAS int*)(lds + 32768 + wave * 5120); LAS float* g_w = (LAS float*)(e_w + 512); LAS float* a_l = g_w + 512; LAS float* s_l = a_l + 128;
    const bf16_t* qp = (const bf16_t*)(ws + WS_R_ZRX);
    const bf16_t* xn = (const bf16_t*)(ws + WS_HB); const float* rs2 = (const float*)(ws + WS_SSQ) + T * 4; const unsigned char* UT = ws + WS_TAB; const unsigned char* VT = UT + (size_t)16384 * 768;
    const float* SU = (const float*)(ws + WS_PSCALE); const float* SV = SU + 16384;
    bf16_t* hb = (bf16_t*)(ws + WS_HB); float* rs3 = (float*)(ws + WS_RS3);
    for (int it = it0; it < it1; ++it) { const int item = gw + it * NGW; if (item >= T / 4) break;
      __builtin_amdgcn_s_setprio(0);
      topk_item(qp, lds, item, e_w, g_w);
      LDS_WAIT();
      __builtin_amdgcn_s_setprio(2);
      for (int tl = 0; tl < 4; ++tl) {
        const int lane = opaque_tid() & 63, li = lane & 15, q = lane >> 4;
        const int tok = item * 4 + tl; LAS int* e_l = e_w + tl * 128; LAS float* g_l = g_w + tl * 128;
        { const int ea = e_l[lane], eb = e_l[lane + 64]; const float ga = g_l[lane], gb = g_l[lane + 64]; const int sa = ea >> 10, sb = eb >> 10;
          const float sua = SU[ea], sub_ = SU[eb], sva = SV[ea], svb = SV[eb]; const f32x4 sq2 = *(const f32x4*)(rs2 + (size_t)tok * 4); const float r2 = 1.0f / sqrtf(((sq2[0] + sq2[1]) + (sq2[2] + sq2[3])) * (1.0f / 1024.0f) + EPS);
          int pa = 0, pb = 0, base = 0;
#pragma unroll
          for (int b = 0; b < 16; ++b) { const unsigned long long ma = __ballot(sa == b), mb = __ballot(sb == b);
              const int ca = __builtin_popcountll(ma), cb = __builtin_popcountll(mb);
              const int ra = (int)__builtin_amdgcn_mbcnt_hi((unsigned)(ma >> 32), __builtin_amdgcn_mbcnt_lo((unsigned)ma, 0u)), rb = (int)__builtin_amdgcn_mbcnt_hi((unsigned)(mb >> 32), __builtin_amdgcn_mbcnt_lo((unsigned)mb, 0u));
              pa = (sa == b) ? base + ra : pa; pb = (sb == b) ? base + ca + rb : pb; base += ca + cb; }
          LDS_WAIT();
          e_l[pa] = ea; g_l[pa] = ga * sva; s_l[pa] = sua * r2; e_l[pb] = eb; g_l[pb] = gb * svb; s_l[pb] = sub_ * r2; }
        f32x2 xf[32];
#pragma unroll
        for (int k = 0; k < 4; ++k) { const u32x4 a = *(const u32x4*)(xn + (size_t)tok * 1024 + (li + 16 * k) * 16), b = *(const u32x4*)(xn + (size_t)tok * 1024 + (li + 16 * k) * 16 + 8);
#pragma unroll
            for (int w = 0; w < 4; ++w) { xf[k * 8 + w] = (f32x2){bf_lo(a[w]), bf_hi(a[w])}; xf[k * 8 + 4 + w] = (f32x2){bf_lo(b[w]), bf_hi(b[w])}; } }
        LDS_WAIT();
        u32x4 cu[3], nu[3];
#define ROWLOAD(DST, TAB, R) do { const unsigned char* rp_ = (TAB) + (size_t)e_l[(R) * 4 + q] * 768 + li * 16; _Pragma("unroll") for (int k_ = 0; k_ < 3; ++k_) DST[k_] = *(const u32x4*)(rp_ + 256 * k_); } while (0)
#define DEC_A(C) __builtin_amdgcn_cvt_scalef32_pk32_f32_fp6((u32x6){C[0][0], C[0][1], C[0][2], C[0][3], C[1][0], C[1][1]}, 1.0f)
#define DEC_B(C) __builtin_amdgcn_cvt_scalef32_pk32_f32_fp6((u32x6){C[1][2], C[1][3], C[2][0], C[2][1], C[2][2], C[2][3]}, 1.0f)
        u32x4 u2[3];
#define UROUND(R, CUR, NXT, LOADS) do { \
            if (LOADS) ROWLOAD(NXT, UT, (R) + 2); \
            __builtin_amdgcn_sched_barrier(0); \
            f32x2 d0 = {0.f, 0.f}, d1 = {0.f, 0.f}; \
            { const f32x32 va = DEC_A(CUR); \
              _Pragma("unroll") for (int j = 0; j < 16; j += 2) { d0 = __builtin_elementwise_fma(xf[j], (f32x2){va[2 * j], va[2 * j + 1]}, d0); d1 = __builtin_elementwise_fma(xf[j + 1], (f32x2){va[2 * j + 2], va[2 * j + 3]}, d1); } } \
            { const f32x32 vb = DEC_B(CUR); \
              _Pragma("unroll") for (int j = 0; j < 16; j += 2) { d0 = __builtin_elementwise_fma(xf[16 + j], (f32x2){vb[2 * j], vb[2 * j + 1]}, d0); d1 = __builtin_elementwise_fma(xf[17 + j], (f32x2){vb[2 * j + 2], vb[2 * j + 3]}, d1); } } \
            const float d = dpp_sum16((d0.x + d0.y) + (d1.x + d1.y)) * s_l[(R) * 4 + q]; \
            if (li == 0) a_l[(R) * 4 + q] = gelu_tanh(d) * g_l[(R) * 4 + q]; \
            __builtin_amdgcn_sched_barrier(0); } while (0)
        ROWLOAD(cu, UT, 0); ROWLOAD(nu, UT, 1);
        for (int r = 0; r < 30; r += 3) { UROUND(r, cu, u2, true); UROUND(r + 1, nu, cu, true); UROUND(r + 2, u2, nu, true); }
        UROUND(30, cu, u2, false); UROUND(31, nu, cu, false);
#undef UROUND
        LDS_WAIT();
        f32x2 acc2[32];
#pragma unroll
        for (int i = 0; i < 32; ++i) acc2[i] = (f32x2){0.f, 0.f};
#define VROUND(R, CUR, NXT, LOADS) do { \
            if (LOADS) ROWLOAD(NXT, VT, (R) + 2); \
            __builtin_amdgcn_sched_barrier(0); \
            const float a = a_l[(R) * 4 + q]; const f32x2 a2 = {a, a}; \
            { const f32x32 va = DEC_A(CUR); \
              _Pragma("unroll") for (int j = 0; j < 16; ++j) acc2[j] = __builtin_elementwise_fma(a2, (f32x2){va[2 * j], va[2 * j + 1]}, acc2[j]); } \
            { const f32x32 vb = DEC_B(CUR); \
              _Pragma("unroll") for (int j = 0; j < 16; ++j) acc2[16 + j] = __builtin_elementwise_fma(a2, (f32x2){vb[2 * j], vb[2 * j + 1]}, acc2[16 + j]); } \
            __builtin_amdgcn_sched_barrier(0); } while (0)
        ROWLOAD(cu, VT, 0); ROWLOAD(nu, VT, 1);
        for (int r = 0; r < 30; r += 3) { VROUND(r, cu, u2, true); VROUND(r + 1, nu, cu, true); VROUND(r + 2, u2, nu, true); }
        VROUND(30, cu, u2, false); VROUND(31, nu, cu, false);
#undef VROUND
#undef ROWLOAD
#undef DEC_A
#undef DEC_B
        float acc[64];
#pragma unroll
        for (int i = 0; i < 32; ++i) { acc[2 * i] = acc2[i].x; acc[2 * i + 1] = acc2[i].y; }
        float fsum[16];
#pragma unroll
        for (int i = 0; i < 16; ++i) {
            auto r0 = __builtin_amdgcn_permlane32_swap(__float_as_uint(acc[i]), __float_as_uint(acc[i + 32]), false, false);
            auto r1 = __builtin_amdgcn_permlane32_swap(__float_as_uint(acc[i + 16]), __float_as_uint(acc[i + 48]), false, false);
            const float t0 = __uint_as_float(r0[0]) + __uint_as_float(r0[1]), t1 = __uint_as_float(r1[0]) + __uint_as_float(r1[1]);
            auto r2 = __builtin_amdgcn_permlane16_swap(__float_as_uint(t0), __float_as_uint(t1), false, false);
            fsum[i] = __uint_as_float(r2[0]) + __uint_as_float(r2[1]); }
        float ss = 0.f; float hv[16];
        { bf16_t* hp = hb + (size_t)tok * 1024 + (li + 16 * q) * 16;
#pragma unroll
            for (int c8 = 0; c8 < 2; ++c8) { const u32x4 h8 = *(const u32x4*)(hp + 8 * c8);
#pragma unroll
                for (int e = 0; e < 4; ++e) { hv[c8 * 8 + 2 * e] = bf_lo(h8[e]) + fsum[c8 * 8 + 2 * e]; hv[c8 * 8 + 2 * e + 1] = bf_hi(h8[e]) + fsum[c8 * 8 + 2 * e + 1]; }
#pragma unroll
                for (int e = 0; e < 8; ++e) ss += hv[c8 * 8 + e] * hv[c8 * 8 + e];
                { u32x4 w; w.x = cvt_pk_bf16(hv[c8 * 8], hv[c8 * 8 + 1]); w.y = cvt_pk_bf16(hv[c8 * 8 + 2], hv[c8 * 8 + 3]); w.z = cvt_pk_bf16(hv[c8 * 8 + 4], hv[c8 * 8 + 5]); w.w = cvt_pk_bf16(hv[c8 * 8 + 6], hv[c8 * 8 + 7]);
                    *(u32x4*)(hp + 8 * c8) = w; } } }
        ss = wave_sum(ss);
        const float rs = 1.0f / sqrtf(ss * (1.0f / 1024.0f) + EPS);
        if (lane == 0) rs3[tok] = rs;
        LDS_WAIT();
      }
    }
    __builtin_amdgcn_s_setprio(0);
    __syncthreads();
}
}
constexpr int LDS_BYTES = 135168 + 256 + 256 + 1024;
static_assert(att::LDS_BYTES <= LDS_BYTES && LRU_END <= LDS_BYTES, "LDS budget");

__device__ __forceinline__ att::Blk make_blk(unsigned char* ws, int L, int sub, int G) {
    int bg, pair; if (G == 256) { bg = (L & 7) * 2 + (L >> 8); pair = (L >> 3) & 31; } else { bg = L >> 5; pair = L & 31; }
    const int qt = (sub < 3) ? (63 - pair) : pair, mode = sub % 3, b = bg >> 1, g = bg & 1, t0 = qt * 64;
    const size_t rowoff = (size_t)(b * S + t0) * 1024 + g * 512;
    att::Blk k;
    k.Q = (const bf16_t*)(ws + (mode == 0 ? WS_R_Q : WS_R_ZRX)) + rowoff; k.O = (bf16_t*)(ws + WS_R_OB) + rowoff;
    if (mode == 0) { k.K = (const bf16_t*)(ws + WS_KC) + (size_t)bg * 256 * 128; k.V = k.K + (size_t)16 * 256 * 128; }
    else { k.K = (const bf16_t*)(ws + WS_R_KV) + (size_t)(2 * mode * 16 + bg) * S * 128; k.V = k.K + (size_t)16 * S * 128; }
    k.gate = (const float*)(ws + WS_GATES) + (size_t)(b * S + t0) * 24 + g * 12 + mode;
    k.sel = (const unsigned*)(ws + WS_SEL) + ((size_t)(b * S + t0) * 2 + g) * 2;
    k.t0 = t0; k.mode = mode;
    const int lowk = t0 - att::WINDOW_W + 1;
    k.jlo = (mode == 2 && lowk > 0) ? lowk / 64 : 0;
    k.NT = mode == 0 ? ((((t0 + 63) - 31) >> 4) >> 6) + 1 : qt + 1 - k.jlo;
    return k;
}


constexpr int NCONV_STEPS = 5;
__device__ __forceinline__ void convert_step(const Params& P, int step) {
    const int tid = opaque_tid(), bid = blockIdx.x, G = gridDim.x; unsigned char* ws = P.ws;
    if (step == 4) {
        const float* p = P.in[I_P]; bf16_t* pb = (bf16_t*)(ws + WS_PB);
        for (int i = bid * NTHREADS + tid; i < T * PLE / 8; i += G * NTHREADS) { const f32x4 a = ((const f32x4*)p)[2 * i], b = ((const f32x4*)p)[2 * i + 1]; ((u32x4*)pb)[i] = pack8(a, b); }
        return; }
    const int li = tid & 15; unsigned char* ut = ws + WS_TAB; float* sct = (float*)(ws + WS_PSCALE);
    for (int r = (step * G + bid) * 32 + (tid >> 4); r < 2 * 16384; r += 4 * G * 32) { const int which = r >> 14; const float* src = P.in[which ? I_PEER_V : I_PEER_U] + (size_t)(r & 16383) * 1024;
        f32x4 v[16]; float mx = 0.f;
#pragma unroll
        for (int k = 0; k < 4; ++k)
#pragma unroll
            for (int c4 = 0; c4 < 4; ++c4) { v[k * 4 + c4] = *(const f32x4*)(src + (li + 16 * k) * 16 + 4 * c4);
                if (!which) v[k * 4 + c4] = v[k * 4 + c4] * *(const f32x4*)(P.in[I_NORM_FFN] + (li + 16 * k) * 16 + 4 * c4);
                mx = fmaxf(fmaxf(mx, fmaxf(fabsf(v[k * 4 + c4][0]), fabsf(v[k * 4 + c4][1]))), fmaxf(fabsf(v[k * 4 + c4][2]), fabsf(v[k * 4 + c4][3]))); }
        mx = peer::dpp_max16(mx);
        const float inv = mx > 0.f ? 7.5f / mx : 0.f;
        u32x4 w[3];
        { f32x16 a0, b0, a1, b1;
#pragma unroll
          for (int i = 0; i < 16; ++i) { a0[i] = v[i >> 1][(2 * i) & 3] * inv; b0[i] = v[i >> 1][(2 * i + 1) & 3] * inv; a1[i] = v[8 + (i >> 1)][(2 * i) & 3] * inv; b1[i] = v[8 + (i >> 1)][(2 * i + 1) & 3] * inv; }
          const u32x6 wa = __builtin_amdgcn_cvt_scalef32_2xpk16_fp6_f32(a0, b0, 1.0f), wb = __builtin_amdgcn_cvt_scalef32_2xpk16_fp6_f32(a1, b1, 1.0f);
          w[0] = (u32x4){wa[0], wa[1], wa[2], wa[3]}; w[1] = (u32x4){wa[4], wa[5], wb[0], wb[1]}; w[2] = (u32x4){wb[2], wb[3], wb[4], wb[5]}; }
        unsigned char* dst = ut + (size_t)r * 768 + li * 16;
#pragma unroll
        for (int k = 0; k < 3; ++k) *(u32x4*)(dst + 256 * k) = w[k];
        if (li == 0) sct[r] = mx * (1.0f / 7.5f); }
}

__global__ void __launch_bounds__(NTHREADS, 2) fwd_megakernel(const Params P_arg) {
#if defined(__HIP_DEVICE_COMPILE__)
    extern __shared__ __attribute__((aligned(16))) unsigned char lds[];
    cg::grid_group grid = cg::this_grid();
    const int G = gridDim.x, bid = blockIdx.x;
    LAS unsigned char* ldsl = (LAS unsigned char*)lds;
    volatile LAS unsigned* bar_st = (volatile LAS unsigned*)(ldsl + 135168 + 240);
    if (threadIdx.x < 4) bar_st[threadIdx.x] = 0u;
    ((volatile LAS int*)(uintptr_t)WID_LDS_OFF)[(unsigned)__builtin_amdgcn_s_getreg((5 << 11) | 4) & 0x3fu] = (int)(threadIdx.x >> 6);
    __syncthreads();
    XcdBarrier xbar;
    { typedef const __attribute__((address_space(4))) Params* kp_t; unsigned char* ws0 = ((kp_t)__builtin_amdgcn_kernarg_segment_ptr())->ws; xbar = xcd_barrier_post((unsigned*)(ws0 + WS_CTL), bar_st); }
    int n_sync = 0;
    if (G == 0x7fffffff) grid.sync();
#define GSYNC() do { xcd_barrier(xbar); ++n_sync; } while (0)
    typedef const __attribute__((address_space(4))) Params* kparams_t;
    const kparams_t Pk = (kparams_t)__builtin_amdgcn_kernarg_segment_ptr();
#define PH_BEGIN() kparams_t pp_ = Pk; asm volatile("" : "+s"(pp_)); const Params P = *pp_; unsigned char* ws = P.ws; (void)ws; \
                   const int tid = opaque_tid(); const int lane = tid & 63, wave = __builtin_amdgcn_readfirstlane(tid >> 6); \
                   const int gw = bid * NWAVES + wave, NGW = G * NWAVES; (void)lane; (void)gw; (void)NGW;

    { PH_BEGIN()
    phase0(P, lds);
    __syncthreads(); }
    GSYNC();
    { PH_BEGIN()
    {
        pg8::Gemm g{(const bf16_t*)(ws + WS_R_XB), (const bf16_t*)(ws + WS_WIN_T), T, 4864, 1024};
        pg8::StaticOrder so; so.init(T, 4864, G, bid);
        EpiZ E{(bf16_t*)(ws + WS_R_ZRX), (bf16_t*)(ws + WS_R_GZ), (bf16_t*)(ws + WS_R_Q), (bf16_t*)(ws + WS_R_KV), (float*)(ws + WS_GATES)};
        pg8::gemm_phase<EpiZ, pg8::StaticOrder, true, true>(ldsl, g, so, E);
    }
    if (G == 256) { if (bid >= 128) side_work(P, lds, (bid - 128) * NWAVES + wave, 128 * NWAVES); }
    else side_work(P, lds, gw, NGW);
    __syncthreads(); }
    GSYNC();
    { PH_BEGIN()
    {
    for (int cu = bid; cu < 256; cu += G) { const int j = cu >> 7, ks = (cu >> 5) & 3, tile = cu & 31;
        pg8::Gemm g{(const bf16_t*)(ws + WS_R_KV) + (size_t)j * 16 * S * 128 + ks * 512, (const bf16_t*)(ws + (j ? WS_W1V_T : WS_W1K_T)) + ks * 512, 4096, 512, 512, 2048, 2048};
        RangeOrder ro{2, tile, 1, 1, 0};
        EpiBf E{(bf16_t*)(ws + WS_G12P) + ((size_t)ks * 2 + j) * 4096 * 512, 512};
        pg8::gemm_phase<EpiBf, RangeOrder, true, true>(ldsl, g, ro, E); }
    }
    for (int unit = bid; unit < 256; unit += G) { int ub = unit >> 5, us = unit & 31;
        if (G == 256) { const int x = unit & 7, k = unit >> 3, grp = (k >> 2) * 8 + x; ub = grp >> 3; us = (grp & 7) * 4 + (k & 3); }
        lru_unit(P, lds, ub, us); }
    {
    rope_k_pass(P);
    }
    __syncthreads(); }
    GSYNC();
    { PH_BEGIN()
    compress_mlp2(P, lds);
    __syncthreads(); }
    GSYNC();
    { PH_BEGIN()
    if (bid & 1) rope_q_pass(P);
    for (int unit = bid; unit < 256; unit += G) att::imp_unit(P, (char*)lds, unit >> 4, unit & 15);
    if (!(bid & 1)) rope_q_pass(P);
    __syncthreads(); }
    GSYNC();
    { PH_BEGIN()
    int cstep = 0;
    if (bid < 512) {
        att::Seam Sm;
        int L = bid, sub = 0, nb = 0;
        att::Blk cur = make_blk(ws, L, 0, G);
        att::attn_prime(cur, (char*)lds, Sm);
        for (;;) {
            int Ln = L, subn = sub + 1; bool last = false;
            if (subn == 6) { subn = 0; Ln = L + G; if (Ln >= 512) { last = true; Ln = L; subn = sub; } }
            const att::Blk nxt = make_blk(ws, Ln, subn, G);
            att::attn_block(cur, nxt, (char*)lds, Sm);
            if ((nb & 1) && cstep < NCONV_STEPS) { convert_step(P, cstep); ++cstep; }
            ++nb;
            if (last) break;
            cur = nxt; L = Ln; sub = subn;
        }
    }
    for (; cstep < NCONV_STEPS; ++cstep) convert_step(P, cstep);
    __syncthreads(); }
    GSYNC();
    { PH_BEGIN()
    {
        pg8::StaticOrder so; so.init(T, 1024, G, bid);
        { pg8::Gemm g{(const bf16_t*)(ws + WS_R_GZ), (const bf16_t*)(ws + WS_WA_T), T, 1024, 1024}; EpiBf E{(bf16_t*)(ws + WS_R_ZRX), 1024};
          pg8::gemm_phase<EpiBf, pg8::StaticOrder, true, true>(ldsl, g, so, E); }
        { pg8::Gemm g{(const bf16_t*)(ws + WS_R_OB), (const bf16_t*)(ws + WS_WB_T), T, 1024, 1024}; EpiBf E{(bf16_t*)(ws + WS_R_KV), 1024};
          pg8::gemm_phase<EpiBf, pg8::StaticOrder, true, true>(ldsl, g, so, E); }
    }
    __syncthreads(); }
    GSYNC();
    { PH_BEGIN()
    {
        pg8::Gemm g{(const bf16_t*)(ws + WS_R_XB), (const bf16_t*)(ws + WS_WM_T), T, 2048, 1024};
        pg8::StaticOrder so; so.init(T, 2048, G, bid);
        EpiMerge E{(const bf16_t*)(ws + WS_R_ZRX), (const bf16_t*)(ws + WS_R_KV), (bf16_t*)(ws + WS_R_GZ)};
        pg8::gemm_phase<EpiMerge, pg8::StaticOrder, true, true>(ldsl, g, so, E);
    }
    __syncthreads(); }
    GSYNC();
    { PH_BEGIN()
    {
        pg8::Gemm g{(const bf16_t*)(ws + WS_R_GZ), (const bf16_t*)(ws + WS_WOUT_T), T, 1024, 1024};
        EpiResidNorm E{P.in[I_X], (bf16_t*)(ws + WS_HB), (unsigned*)(ws + WS_SSQ) + T * 4, (unsigned*)(ws + WS_CTL), ldsl, 32u};
        PanelOrder po;
        if (G == 256) { const int x = bid & 7, k = bid >> 3; po.pm = x * 8 + (k >> 2); po.pn = k & 3; po.dpm = 64; po.n = 2; }
        else { const int Gr = G >= 512 ? 512 : (G & ~3); po.pm = bid >> 2; po.pn = bid & 3; po.dpm = Gr >> 2; po.n = (bid < Gr) ? (512 - bid + Gr - 1) / Gr : 0; }
        pg8::gemm_phase<EpiResidNorm, PanelOrder, true, true>(ldsl, g, po, E);
    }
    __syncthreads(); }
    GSYNC();
    { PH_BEGIN()
    {
        pg8::StaticOrder so; so.init(T, 1024, G, bid);
        { pg8::Gemm g{(const bf16_t*)(ws + WS_HB), (const bf16_t*)(ws + WS_WQ_T), T, 1024, 1024}; EpiBfRs E{(bf16_t*)(ws + WS_R_ZRX), 1024, (const float*)(ws + WS_SSQ) + T * 4};
          pg8::gemm_phase<EpiBfRs, pg8::StaticOrder, true, true>(ldsl, g, so, E); }
    }
    __syncthreads(); }
    GSYNC();
    { PH_BEGIN()
    const int nit = (T / 4 + NGW - 1) / NGW, mid = (bid & 1) ? (nit + 1) / 2 : 0;
    if (mid > 0) peer::peer_phase(P, lds, 0, mid);
    { pg8::Gemm g{(const bf16_t*)(ws + WS_PB), (const bf16_t*)(ws + WS_WP_T), T, 1024, 256}; EpiBf E{(bf16_t*)(ws + WS_R_GZ), 1024};
      RangeOrder ro{4, 0, 512, G, bid};
      pg8::gemm_phase<EpiBf, RangeOrder, true, true>(ldsl, g, ro, E);
      __syncthreads(); }
    peer::peer_phase(P, lds, mid, nit);
    __syncthreads(); }
    GSYNC();
    { PH_BEGIN()
    {
        pg8::Gemm g{(const bf16_t*)(ws + WS_HB), (const bf16_t*)(ws + WS_WG_T), T, 1024, 1024};
        EpiPleNorm E{(const bf16_t*)(ws + WS_HB), P.out, (const bf16_t*)(ws + WS_R_GZ), P.in[I_NORM_FINAL], (const float*)(ws + WS_RS3), (unsigned*)(ws + WS_SSQ), (unsigned*)(ws + WS_CTL), ldsl, 32u};
        PanelOrder po;
        if (G == 256) { const int x = bid & 7, k = bid >> 3; po.pm = x * 8 + (k >> 2); po.pn = k & 3; po.dpm = 64; po.n = 2; }
        else { const int Gr = G >= 512 ? 512 : (G & ~3); po.pm = bid >> 2; po.pn = bid & 3; po.dpm = Gr >> 2; po.n = (bid < Gr) ? (512 - bid + Gr - 1) / Gr : 0; }
        pg8::gemm_phase<EpiPleNorm, PanelOrder, true, true>(ldsl, g, po, E);
    }
    __syncthreads(); }
#endif
}

extern "C" void kernel_launch(void* const* d_in, const int* in_sizes, int n_in, void* d_out, int out_size, void* d_ws, size_t ws_size, hipStream_t stream) {
    static int grid_blocks = 0;
    if (grid_blocks == 0) {
        if (n_in != 34 || out_size != T * D || ws_size < WS_END) { fprintf(stderr, "kernel_launch: unexpected shapes (n_in %d out %d ws %zu)\n", n_in, out_size, ws_size); grid_blocks = -1; return; }
        int dev = 0, cus = 0, per_cu = 0;
        (void)hipGetDevice(&dev);
        (void)hipDeviceGetAttribute(&cus, hipDeviceAttributeMultiprocessorCount, dev);
        if (hipFuncSetAttribute((const void*)fwd_megakernel, hipFuncAttributeMaxDynamicSharedMemorySize, LDS_BYTES) != hipSuccess) { fprintf(stderr, "kernel_launch: hipFuncSetAttribute failed\n"); grid_blocks = -1; return; }
        (void)hipOccupancyMaxActiveBlocksPerMultiprocessor(&per_cu, (const void*)fwd_megakernel, NTHREADS, LDS_BYTES);
        if (per_cu < 1 || cus < 1) { fprintf(stderr, "kernel_launch: occupancy query says %d blocks per CU (%d CUs)\n", per_cu, cus); grid_blocks = -1; return; }
        grid_blocks = cus;
    }
    if (grid_blocks < 0) return;
    Params p{};
    for (int i = 0; i < 34; ++i) p.in[i] = (const float*)d_in[i];
    p.out = (float*)d_out; p.ws = (unsigned char*)d_ws;
    (void)hipMemsetAsync((char*)d_ws + WS_CTL, 0, 65536, stream);
    void* args[] = {&p};
    hipError_t e = hipLaunchCooperativeKernel((const void*)fwd_megakernel, dim3(grid_blocks), dim3(NTHREADS), args, LDS_BYTES, stream);
    if (e != hipSuccess) fprintf(stderr, "cooperative launch failed: %s (grid %d)\n", hipGetErrorString(e), grid_blocks);
}
```
